# Optimizing an MI355X kernel written in HIP

```python
import jax, jax.numpy as jnp
from jax import lax
import numpy as np

D_MODEL = 1024
BATCH = 8
SEQ = 8192
DEPTH = 2
DEC_BATCH = 16
DEC_SEQ = 2048
PAST_LEN = 128

HEAD_DIM = 64
A_Q_HEADS = 16
A_KV_HEADS = 4
A_RADIUS = 128
B_GROUPS = ((128, 1), (512, 4), (2048, 16))
B_Q_PER_GROUP = 6
B_KV_PER_GROUP = 2
B_Q_HEADS = B_Q_PER_GROUP * len(B_GROUPS)
B_KV_HEADS = B_KV_PER_GROUP * len(B_GROUPS)
FFN_HIDDEN = -(-8 * D_MODEL // (3 * 256)) * 256
PLE_DIM = 256
N_A_LAYERS = (DEPTH + 1) // 2
N_B_LAYERS = DEPTH // 2
EPS = 1e-6
NEG_INF = -1e30

kernel_name = "hybrid_window_dilated_encoder"


def alibi_slopes(n):
    return 2.0 ** (-8.0 * jnp.arange(1, n + 1, dtype=jnp.float32) / n)


def rmsnorm(x, g):
    xf = x.astype(jnp.float32)
    y = xf * lax.rsqrt(jnp.mean(xf * xf, axis=-1, keepdims=True) + EPS) * g.astype(jnp.float32)
    return y.astype(x.dtype)


def banded_attention(q, k, v, slopes, radius, stride, sink):
    n, length, hq, hd = q.shape
    hkv = k.shape[2]
    grp = hq // hkv
    blk = radius
    nb = -(-length // blk)
    lp = nb * blk
    q = jnp.pad(q, ((0, 0), (0, lp - length), (0, 0), (0, 0)))
    kv_pad = ((0, 0), (blk, lp - length + blk), (0, 0), (0, 0))
    k = jnp.pad(k, kv_pad)
    v = jnp.pad(v, kv_pad)
    qb = q.reshape(n, nb, blk, hkv, grp, hd)

    def windows(t):
        tb = t.reshape(n, nb + 2, blk, hkv, hd)
        return jnp.concatenate([tb[:, :-2], tb[:, 1:-1], tb[:, 2:]], axis=2)

    kw, vw = windows(k), windows(v)
    logits = jnp.einsum('nbqkgd,nbskd->nbkgqs', qb, kw, preferred_element_type=jnp.float32)
    qpos = jnp.arange(lp).reshape(nb, blk)
    kpos = (jnp.arange(nb)[:, None] - 1) * blk + jnp.arange(3 * blk)[None, :]
    dist = jnp.abs(qpos[:, :, None] - kpos[:, None, :])
    valid = (dist <= radius) & (kpos[:, None, :] >= 0) & (kpos[:, None, :] < length)
    alibi = -slopes.astype(jnp.float32).reshape(hkv, grp)[None, :, :, None, None] * \
        (stride * dist).astype(jnp.float32)[:, None, None]
    logits = jnp.where(valid[:, None, None], logits + alibi, NEG_INF)
    m = logits.max(axis=-1)
    if sink is not None:
        s = sink.astype(jnp.float32).reshape(hkv, grp)[:, :, None]
        m = jnp.maximum(m, s)
    p = jnp.exp(logits - m[..., None])
    denom = p.sum(axis=-1)
    if sink is not None:
        denom = denom + jnp.exp(s - m)
    o = jnp.einsum('nbkgqs,nbskd->nbqkgd', p.astype(v.dtype), vw, preferred_element_type=jnp.float32)
    o = o / denom.transpose(0, 1, 4, 2, 3)[..., None]
    o = o.reshape(n, lp, hq, hd)[:, :length].astype(q.dtype)
    lse = (m + jnp.log(denom)).transpose(0, 1, 4, 2, 3).reshape(n, lp, hq)[:, :length]
    return o, lse


def split_qkv(h, wqkv, hq, hkv, q_gain, k_gain):
    b, s, _ = h.shape
    qkv = h @ wqkv
    q = qkv[..., :hq * HEAD_DIM].reshape(b, s, hq, HEAD_DIM)
    k = qkv[..., hq * HEAD_DIM:(hq + hkv) * HEAD_DIM].reshape(b, s, hkv, HEAD_DIM)
    v = qkv[..., (hq + hkv) * HEAD_DIM:].reshape(b, s, hkv, HEAD_DIM)
    q = rmsnorm(q, q_gain) * jnp.asarray(HEAD_DIM ** -0.5, dtype=h.dtype)
    k = rmsnorm(k, k_gain)
    return q, k, v


def mixer_window_gqa(h, wqkv, wo, q_gain, k_gain, sink):
    b, s, _ = h.shape
    q, k, v = split_qkv(h, wqkv, A_Q_HEADS, A_KV_HEADS, q_gain, k_gain)
    o, _ = banded_attention(q, k, v, alibi_slopes(A_Q_HEADS), A_RADIUS, 1, sink)
    return o.reshape(b, s, A_Q_HEADS * HEAD_DIM) @ wo


def mixer_dilated(h, wqkv, wo, q_gain, k_gain):
    b, s, _ = h.shape
    q, k, v = split_qkv(h, wqkv, B_Q_HEADS, B_KV_HEADS, q_gain, k_gain)
    slopes = alibi_slopes(B_Q_HEADS)
    outs, lses = [], []
    for g, (window, dil) in enumerate(B_GROUPS):
        radius = window // (2 * dil)
        qs = slice(g * B_Q_PER_GROUP, (g + 1) * B_Q_PER_GROUP)
        ks = slice(g * B_KV_PER_GROUP, (g + 1) * B_KV_PER_GROUP)

        def to_res(t):
            hh = t.shape[2]
            return t.reshape(b, s // dil, dil, hh, HEAD_DIM).transpose(0, 2, 1, 3, 4).reshape(b * dil, s // dil, hh, HEAD_DIM)

        o, lse = banded_attention(to_res(q[:, :, qs]), to_res(k[:, :, ks]), to_res(v[:, :, ks]),
                                  slopes[qs], radius, dil, None)
        o = o.reshape(b, dil, s // dil, B_Q_PER_GROUP, HEAD_DIM).transpose(0, 2, 1, 3, 4).reshape(b, s, B_Q_PER_GROUP, HEAD_DIM)
        lse = lse.reshape(b, dil, s // dil, B_Q_PER_GROUP).transpose(0, 2, 1, 3).reshape(b, s, B_Q_PER_GROUP)
        outs.append(o)
        lses.append(lse)
    alpha = jax.nn.softmax(jnp.stack(lses, axis=0), axis=0)
    o = jnp.concatenate([outs[g] * alpha[g][..., None].astype(h.dtype) for g in range(len(B_GROUPS))], axis=2)
    return o.reshape(b, s, B_Q_HEADS * HEAD_DIM) @ wo


def swiglu(h, w_gate, w_up, w_down):
    return (jax.nn.silu(h @ w_gate) * (h @ w_up)) @ w_down


def encoder_trunk(x, p, norm_mix, norm_ffn, norm_ple,
                  a_wqkv, a_wo, a_q_gain, a_k_gain, a_sink,
                  b_wqkv, b_wo, b_q_gain, b_k_gain,
                  ffn_w_gate, ffn_w_up, ffn_w_down, ple_w_gate, ple_w_proj):
    for i in range(DEPTH):
        hn = rmsnorm(x, norm_mix[i])
        j = i // 2
        if i % 2 == 0:
            mix = mixer_window_gqa(hn, a_wqkv[j], a_wo[j], a_q_gain[j], a_k_gain[j], a_sink[j])
        else:
            mix = mixer_dilated(hn, b_wqkv[j], b_wo[j], b_q_gain[j], b_k_gain[j])
        x = x + mix
        x = x + swiglu(rmsnorm(x, norm_ffn[i]), ffn_w_gate[i], ffn_w_up[i], ffn_w_down[i])
        gate = jax.nn.sigmoid(rmsnorm(x, norm_ple[i]) @ ple_w_gate[i])
        x = x + gate * (p[i] @ ple_w_proj[i])
    return x


def setup_inputs(seed: int = 0) -> dict:
    key = jax.random.key(seed)
    ks = jax.random.split(key, 24)
    f32 = jnp.float32

    def w(k, shape, fan_in):
        return jax.random.normal(k, shape, f32) * fan_in ** -0.5

    def gain(k, shape):
        return 1.0 + 0.02 * jax.random.normal(k, shape, f32)

    a_cols = (A_Q_HEADS + 2 * A_KV_HEADS) * HEAD_DIM
    b_cols = (B_Q_HEADS + 2 * B_KV_HEADS) * HEAD_DIM
    return {
        "x_prompt": jax.random.normal(ks[0], (BATCH, SEQ, D_MODEL), f32),
        "x_sample": jax.random.normal(ks[1], (DEC_BATCH, DEC_SEQ, D_MODEL), f32),
        "p_prompt": jax.random.normal(ks[2], (DEPTH, BATCH, SEQ, PLE_DIM), f32),
        "p_sample": jax.random.normal(ks[3], (DEPTH, DEC_BATCH, DEC_SEQ, PLE_DIM), f32),
        "norm_mix": gain(ks[4], (DEPTH, D_MODEL)),
        "norm_ffn": gain(ks[5], (DEPTH, D_MODEL)),
        "norm_ple": gain(ks[6], (DEPTH, D_MODEL)),
        "a_wqkv": w(ks[7], (N_A_LAYERS, D_MODEL, a_cols), D_MODEL),
        "a_wo": w(ks[8], (N_A_LAYERS, A_Q_HEADS * HEAD_DIM, D_MODEL), A_Q_HEADS * HEAD_DIM),
        "a_q_gain": gain(ks[9], (N_A_LAYERS, HEAD_DIM)),
        "a_k_gain": gain(ks[10], (N_A_LAYERS, HEAD_DIM)),
        "a_sink": 0.5 * jax.random.normal(ks[11], (N_A_LAYERS, A_Q_HEADS), f32),
        "b_wqkv": w(ks[12], (N_B_LAYERS, D_MODEL, b_cols), D_MODEL),
        "b_wo": w(ks[13], (N_B_LAYERS, B_Q_HEADS * HEAD_DIM, D_MODEL), B_Q_HEADS * HEAD_DIM),
        "b_q_gain": gain(ks[14], (N_B_LAYERS, HEAD_DIM)),
        "b_k_gain": gain(ks[15], (N_B_LAYERS, HEAD_DIM)),
        "ffn_w_gate": w(ks[16], (DEPTH, D_MODEL, FFN_HIDDEN), D_MODEL),
        "ffn_w_up": w(ks[17], (DEPTH, D_MODEL, FFN_HIDDEN), D_MODEL),
        "ffn_w_down": w(ks[18], (DEPTH, FFN_HIDDEN, D_MODEL), FFN_HIDDEN),
        "ple_w_gate": w(ks[19], (DEPTH, D_MODEL, D_MODEL), D_MODEL),
        "ple_w_proj": w(ks[20], (DEPTH, PLE_DIM, D_MODEL), PLE_DIM),
    }


def reference(x_prompt, x_sample, p_prompt, p_sample, norm_mix, norm_ffn, norm_ple,
              a_wqkv, a_wo, a_q_gain, a_k_gain, a_sink,
              b_wqkv, b_wo, b_q_gain, b_k_gain,
              ffn_w_gate, ffn_w_up, ffn_w_down, ple_w_gate, ple_w_proj):
    y_prompt = encoder_trunk(x_prompt, p_prompt, norm_mix, norm_ffn, norm_ple,
                             a_wqkv, a_wo, a_q_gain, a_k_gain, a_sink,
                             b_wqkv, b_wo, b_q_gain, b_k_gain,
                             ffn_w_gate, ffn_w_up, ffn_w_down, ple_w_gate, ple_w_proj)
    y_sample = encoder_trunk(x_sample, p_sample, norm_mix, norm_ffn, norm_ple,
                             a_wqkv, a_wo, a_q_gain, a_k_gain, a_sink,
                             b_wqkv, b_wo, b_q_gain, b_k_gain,
                             ffn_w_gate, ffn_w_up, ffn_w_down, ple_w_gate, ple_w_proj)
    return (y_prompt, y_sample)
```

```cpp
#include <hip/hip_runtime.h>
#include <hip/hip_cooperative_groups.h>
#include <cstdio>
#include <cstdint>
#include <cmath>
namespace cg = cooperative_groups;

#ifndef MK_SINGLE
#define MK_SINGLE 1
#endif

#define LAS __attribute__((address_space(3)))
typedef unsigned short bf16_t;
typedef short bf16x8 __attribute__((ext_vector_type(8)));
typedef float f32x4 __attribute__((ext_vector_type(4)));
typedef float f32x16 __attribute__((ext_vector_type(16)));
typedef unsigned u32x4 __attribute__((ext_vector_type(4)));
typedef unsigned u32x2 __attribute__((ext_vector_type(2)));

constexpr int DM = 1024, MTOT = 98304, MPROMPT = 65536, LP = 8192, LS = 2048;
constexpr int FFN = 2816, PLE = 256;
constexpr int VTP = MTOT + 128;
constexpr int A_NQ = 16, A_NKV = 4, B_NQ = 18, B_NKV = 6;
constexpr float EPS = 1e-6f, LOG2E = 1.4426950408889634f;

typedef float f32x2_t __attribute__((ext_vector_type(2))); typedef __bf16 bf16x2_t __attribute__((ext_vector_type(2)));
__device__ __forceinline__ unsigned cvt_pk_bf16(float lo, float hi) { f32x2_t v = {lo, hi}; bf16x2_t b = __builtin_convertvector(v, bf16x2_t); return __builtin_bit_cast(unsigned, b); }
__device__ __forceinline__ float bflo(unsigned w) { return __uint_as_float(w << 16); }
__device__ __forceinline__ float bfhi(unsigned w) { return __uint_as_float(w & 0xffff0000u); }
__device__ __forceinline__ float wave_sum(float v) {
#pragma unroll
    for (int o = 1; o < 64; o <<= 1) v += __shfl_xor(v, o);
    return v;
}
__device__ __forceinline__ float row_rstd(const float* ss, int row) {
    const f32x4* p = (const f32x4*)(ss + (size_t)row * 16);
    const f32x4 a = p[0], b = p[1], c = p[2], d = p[3];
    const float s = (((a.x + a.y) + (a.z + a.w)) + ((b.x + b.y) + (b.z + b.w))) + (((c.x + c.y) + (c.z + c.w)) + ((d.x + d.y) + (d.z + d.w)));
    return rsqrtf(s * (1.0f / 1024.0f) + EPS);
}

__device__ __forceinline__ void rows_rstd8(const float* ss, int row0, int lane, float (&rs)[8]) {
    const int fq = lane >> 4, fr = lane & 15;
    float mine[2];
#pragma unroll
    for (int j = 0; j < 2; ++j) { const int k = 2 * fq + j; mine[j] = row_rstd(ss, row0 + 128 * (k >> 2) + 16 * (k & 3)); }
#pragma unroll
    for (int k = 0; k < 8; ++k) rs[k] = __shfl(mine[k & 1], fr + 16 * (k >> 1));
}

namespace pg8 {
constexpr int BM = 256, BK = 64, HALF = 128, HTB = HALF * BK * 2, STAGE_BYTES = 8 * HTB, NXCD = 8, WGM = 8;
__host__ __device__ __forceinline__ int lds_byte(int r, int c) { const int st = (r >> 4) * 2 + (c >> 5), rr = r & 15, cc = c & 31, ob = rr * 64 + cc * 2; return st * 1024 + (ob ^ (((ob >> 9) & 1) << 5)); }
__host__ __device__ __forceinline__ void stage_rc(int b, int& R, int& C) { const int st = b / 1024, sb = b % 1024, swz = sb ^ (((sb >> 9) & 1) << 5); R = (st >> 1) * 16 + swz / 64; C = (st & 1) * 32 + (swz % 64) / 2; }
__host__ __device__ __forceinline__ int perm32(int rho) { const int n = rho >> 4, i = rho & 15; return 8 * (i >> 2) + 4 * n + (i & 3); }

struct Unit { int pm, pn; };
struct Gemm { const bf16_t* A; const bf16_t* Bt; int M, N, K; };

struct StaticOrder {
    int nM, nN, nwg, G, c, rev;
    __host__ __device__ void init(int M, int N, int G_, int c_, int rev_ = 0) { nM = M / BM; nN = N / BM; nwg = nM * nN; G = G_; c = c_; rev = rev_; }
    __host__ __device__ bool next(int i, Unit& u) const {
        const long L = (long)i * G + c; if (L >= nwg) return false;
        int wgid = (int)L; { const int q = nwg / NXCD, r = nwg % NXCD, xcd = wgid % NXCD, off = wgid / NXCD; wgid = (xcd < r ? xcd * (q + 1) : r * (q + 1) + (xcd - r) * q) + off; }
        const int nig = WGM * nN, gid = wgid / nig, fm = gid * WGM, gsz = (nM - fm) < WGM ? (nM - fm) : WGM;
        u.pm = fm + ((wgid % nig) % gsz); u.pn = (wgid % nig) / gsz; if (rev) u.pm = nM - 1 - u.pm; return true;
    }
};

template <class Epi, class Sched, bool ALIGN_EPI = true>
__device__ __forceinline__ void gemm_phase(LAS unsigned char* lds, const Gemm g, const Sched& S, const Epi& E) {
    int tid_ = threadIdx.x; asm volatile("" : "+v"(tid_));
    const int tid = tid_, wid = __builtin_amdgcn_readfirstlane(tid >> 6), lane = tid & 63, wr = wid >> 2, wc = wid & 3, fr = lane & 15, fq = lane >> 4;
    int K_ = g.K; asm volatile("" : "+s"(K_));
    const int K = K_, nt = K / BK;
    unsigned voffA[2], voffB[2];
#pragma unroll
    for (int i = 0; i < 2; ++i) { int R, C; stage_rc(tid * 16 + i * 8192, R, C); const int Rb = (R & ~31) + perm32(R & 31);
        voffA[i] = (unsigned)(R * K + C) * 2u; voffB[i] = (unsigned)(Rb * K + C) * 2u; }
    const size_t kstep = (size_t)(BK * 2);
    const size_t hstep = (size_t)HALF * K * 2;
    const size_t tstep = 2 * hstep;
    const unsigned ldsw = (unsigned)wid * 1024u;
    const int aoff = lds_byte(wr * 64 + fr, fq * 8), boff = lds_byte(wc * 32 + fr, fq * 8);
#define PG8_SA(b, h) (((b) * 2 + (h)) * HTB)
#define PG8_SB(b, h) ((4 + (b) * 2 + (h)) * HTB)
#define PG8_STAGE(bufoff, gbase, voff) do { _Pragma("unroll") for (int _i = 0; _i < 2; ++_i) \
        __builtin_amdgcn_global_load_lds((const unsigned*)((const char*)(gbase) + (voff)[_i]), (LAS unsigned*)(lds + (bufoff) + ldsw + _i * 8192), 16, 0, 0); } while (0)
#define PG8_LDA(dst, b, h) do { _Pragma("unroll") for (int m = 0; m < 4; ++m) _Pragma("unroll") for (int k = 0; k < 2; ++k) dst[m][k] = *(const LAS bf16x8*)(lds + PG8_SA(b, h) + aoff + m * 2048 + k * 1024); } while (0)
#define PG8_LDB(dst, b, h) do { _Pragma("unroll") for (int n = 0; n < 2; ++n) _Pragma("unroll") for (int k = 0; k < 2; ++k) dst[n][k] = *(const LAS bf16x8*)(lds + PG8_SB(b, h) + boff + n * 2048 + k * 1024); } while (0)
#define PG8_MMA(ai, bj, At, Bt) do { __builtin_amdgcn_s_setprio(1); _Pragma("unroll") for (int m = 0; m < 4; ++m) _Pragma("unroll") for (int n = 0; n < 2; ++n) _Pragma("unroll") for (int k = 0; k < 2; ++k) \
        acc[ai][bj][m][n] = __builtin_amdgcn_mfma_f32_16x16x32_bf16(Bt[n][k], At[m][k], acc[ai][bj][m][n], 0, 0, 0); __builtin_amdgcn_s_setprio(0); } while (0)
#define PG8_WAIT_V(n) asm volatile("s_waitcnt vmcnt(" #n ")" ::: "memory")
#define PG8_WAIT_L(n) asm volatile("s_waitcnt lgkmcnt(" #n ")" ::: "memory")
#define PG8_BAR __builtin_amdgcn_s_barrier()
#define PG8_SCHED __builtin_amdgcn_sched_barrier(0)
    Unit cur, nxt; int ui = 0;
    if (!S.next(0, cur)) return;
    f32x4 acc[2][2][4][2];
#pragma unroll
    for (int a = 0; a < 2; ++a)
#pragma unroll
        for (int b = 0; b < 2; ++b)
#pragma unroll
            for (int m = 0; m < 4; ++m)
#pragma unroll
                for (int n = 0; n < 2; ++n) acc[a][b][m][n] = (f32x4){0.f, 0.f, 0.f, 0.f};
    bf16x8 At[4][2], B0[2][2], B1[2][2];
    const char* cA = (const char*)g.A + (size_t)cur.pm * tstep; const char* cB = (const char*)g.Bt + (size_t)cur.pn * tstep;
    PG8_STAGE(PG8_SB(0, 0), cB, voffB); PG8_STAGE(PG8_SB(0, 1), cB + hstep, voffB); PG8_STAGE(PG8_SA(0, 0), cA, voffA); PG8_STAGE(PG8_SA(0, 1), cA + hstep, voffA);
    if (wr == 1) PG8_BAR;
    PG8_WAIT_V(2); PG8_BAR;
    PG8_STAGE(PG8_SB(1, 0), cB + kstep, voffB); PG8_STAGE(PG8_SA(1, 0), cA + kstep, voffA); PG8_STAGE(PG8_SB(1, 1), cB + hstep + kstep, voffB);
    PG8_WAIT_V(6); PG8_BAR;
    for (;;) {
        const bool has_next = S.next(ui + 1, nxt);
        const char* nA = has_next ? (const char*)g.A + (size_t)nxt.pm * tstep : cA; const char* nB = has_next ? (const char*)g.Bt + (size_t)nxt.pn * tstep : cB;
        for (int t = 0; t < nt; t += 2) {
            const bool last = (t == nt - 2);
            const char* a1 = cA + (size_t)(t + 1) * kstep;
            const char* a2 = last ? nA : cA + (size_t)(t + 2) * kstep; const char* b2 = last ? nB : cB + (size_t)(t + 2) * kstep;
            const char* a3 = a2 + kstep; const char* b3 = b2 + kstep;
            PG8_LDB(B0, 0, 0); PG8_LDB(B1, 0, 1); PG8_SCHED; PG8_LDA(At, 0, 0); PG8_STAGE(PG8_SA(1, 1), a1 + hstep, voffA);
            PG8_WAIT_V(8); PG8_WAIT_L(0); PG8_BAR; PG8_MMA(0, 0, At, B0); PG8_MMA(0, 1, At, B1); PG8_BAR; PG8_SCHED;
            PG8_LDA(At, 0, 1); PG8_STAGE(PG8_SB(0, 0), b2, voffB); PG8_STAGE(PG8_SB(0, 1), b2 + hstep, voffB); PG8_STAGE(PG8_SA(0, 0), a2, voffA);
            PG8_WAIT_V(8); PG8_WAIT_L(0); PG8_BAR; PG8_MMA(1, 0, At, B0); PG8_MMA(1, 1, At, B1); PG8_BAR; PG8_SCHED;
            PG8_LDB(B0, 1, 0); PG8_LDB(B1, 1, 1); PG8_SCHED; PG8_LDA(At, 1, 0); PG8_STAGE(PG8_SA(0, 1), a2 + hstep, voffA);
            PG8_WAIT_V(8); PG8_WAIT_L(0); PG8_BAR; PG8_MMA(0, 0, At, B0); PG8_MMA(0, 1, At, B1); PG8_BAR; PG8_SCHED;
            PG8_LDA(At, 1, 1); PG8_STAGE(PG8_SB(1, 0), b3, voffB); PG8_STAGE(PG8_SB(1, 1), b3 + hstep, voffB); PG8_STAGE(PG8_SA(1, 0), a3, voffA);
            PG8_WAIT_V(8); PG8_WAIT_L(0); PG8_BAR; PG8_MMA(1, 0, At, B0); PG8_MMA(1, 1, At, B1); PG8_BAR; PG8_SCHED;
        }
        if constexpr (ALIGN_EPI) { if (wr == 0) PG8_BAR; }
        E(acc, cur, wr, wc, fr, fq);
        if (!has_next) break;
#pragma unroll
        for (int a = 0; a < 2; ++a)
#pragma unroll
            for (int b = 0; b < 2; ++b)
#pragma unroll
                for (int m = 0; m < 4; ++m)
#pragma unroll
                    for (int n = 0; n < 2; ++n) acc[a][b][m][n] = (f32x4){0.f, 0.f, 0.f, 0.f};
        cur = nxt; cA = nA; cB = nB; ++ui;
        if constexpr (ALIGN_EPI) { if (wr == 1) PG8_BAR; }
    }
    PG8_WAIT_V(0);
    if constexpr (!ALIGN_EPI) { if (wr == 0) PG8_BAR; }
    PG8_BAR;
#undef PG8_SA
#undef PG8_SB
#undef PG8_STAGE
#undef PG8_LDA
#undef PG8_LDB
#undef PG8_MMA
#undef PG8_WAIT_V
#undef PG8_WAIT_L
#undef PG8_BAR
#undef PG8_SCHED
}

struct EpiPlain {
    bf16_t* O; int ldc;
    __device__ __forceinline__ void operator()(const f32x4 (&acc)[2][2][4][2], const Unit& u, int wr, int wc, int fr, int fq) const {
        const int row0 = u.pm * BM + wr * 64 + fr, col0 = u.pn * BM + wc * 32 + 8 * fq;
#pragma unroll
        for (int ai = 0; ai < 2; ++ai)
#pragma unroll
            for (int m = 0; m < 4; ++m) { bf16_t* rowp = O + (size_t)(row0 + ai * HALF + m * 16) * ldc + col0;
#pragma unroll
                for (int bj = 0; bj < 2; ++bj) { const f32x4 v0 = acc[ai][bj][m][0], v1 = acc[ai][bj][m][1];
                    u32x4 w; w.x = cvt_pk_bf16(v0[0], v0[1]); w.y = cvt_pk_bf16(v0[2], v0[3]); w.z = cvt_pk_bf16(v1[0], v1[1]); w.w = cvt_pk_bf16(v1[2], v1[3]);
                    *(u32x4*)(rowp + bj * HALF) = w; } }
    }
};

template <bool LB> struct EpiQKV {
    bf16_t* Q; bf16_t* Kb; bf16_t* VT; const float* ss; const float* qgain; const float* kgain;
    __device__ __forceinline__ void operator()(const f32x4 (&acc)[2][2][4][2], const Unit& u, int wr, int wc, int fr, int fq) const {
        constexpr int NQ = LB ? B_NQ : A_NQ, NKV = LB ? B_NKV : A_NKV, LDQ = NQ * 64, LDK = NKV * 64;
        const int head = u.pn * 4 + wc;
        if (head >= NQ + 2 * NKV) return;
        const int kind = head < NQ ? 0 : (head < NQ + NKV ? 1 : 2);
        const int row0 = u.pm * BM + wr * 64 + fr;
        if (kind < 2) {
            const float* gp = (kind == 0 ? qgain : kgain) + 8 * fq;
            f32x4 gv[2][2];
#pragma unroll
            for (int bj = 0; bj < 2; ++bj)
#pragma unroll
                for (int n = 0; n < 2; ++n) gv[bj][n] = *(const f32x4*)(gp + 32 * bj + 4 * n);
            const float post = kind == 0 ? 0.125f * LOG2E : 1.0f;
            bf16_t* base = kind == 0 ? (Q + head * 64 + 8 * fq) : (Kb + (head - NQ) * 64 + 8 * fq);
            const int ld = kind == 0 ? LDQ : LDK;
            float rs8[8]; rows_rstd8(ss, row0, fq * 16 + fr, rs8);
#pragma unroll
            for (int ai = 0; ai < 2; ++ai)
#pragma unroll
                for (int m = 0; m < 4; ++m) {
                    const int row = row0 + ai * HALF + m * 16;
                    float s2 = 0.f;
#pragma unroll
                    for (int bj = 0; bj < 2; ++bj)
#pragma unroll
                        for (int n = 0; n < 2; ++n) { const f32x4 a = acc[ai][bj][m][n]; s2 += (a[0] * a[0] + a[1] * a[1]) + (a[2] * a[2] + a[3] * a[3]); }
                    s2 += __shfl_xor(s2, 16); s2 += __shfl_xor(s2, 32);
                    const float rs = rs8[ai * 4 + m];
                    const float sc = rs * rsqrtf(rs * rs * s2 * (1.0f / 64.0f) + EPS) * post;
                    bf16_t* rowp = base + (size_t)row * ld;
#pragma unroll
                    for (int bj = 0; bj < 2; ++bj) { const f32x4 v0 = acc[ai][bj][m][0] * sc * gv[bj][0], v1 = acc[ai][bj][m][1] * sc * gv[bj][1];
                        u32x4 w; w.x = cvt_pk_bf16(v0[0], v0[1]); w.y = cvt_pk_bf16(v0[2], v0[3]); w.z = cvt_pk_bf16(v1[0], v1[1]); w.w = cvt_pk_bf16(v1[2], v1[3]);
                        *(u32x4*)(rowp + 32 * bj) = w; }
                }
        } else {
            bf16_t* base = VT + (head - NQ - NKV) * 64 + 8 * fq;
            float rs8[8]; rows_rstd8(ss, row0, fq * 16 + fr, rs8);
#pragma unroll
            for (int ai = 0; ai < 2; ++ai)
#pragma unroll
                for (int m = 0; m < 4; ++m) {
                    const int row = row0 + ai * HALF + m * 16;
                    const float rs = rs8[ai * 4 + m];
                    bf16_t* rowp = base + (size_t)row * LDK;
#pragma unroll
                    for (int bj = 0; bj < 2; ++bj) { const f32x4 v0 = acc[ai][bj][m][0] * rs, v1 = acc[ai][bj][m][1] * rs;
                        u32x4 w; w.x = cvt_pk_bf16(v0[0], v0[1]); w.y = cvt_pk_bf16(v0[2], v0[3]); w.z = cvt_pk_bf16(v1[0], v1[1]); w.w = cvt_pk_bf16(v1[2], v1[3]);
                        *(u32x4*)(rowp + 32 * bj) = w; }
                }
        }
    }
};

struct EpiResid {
    bf16_t* X; float* ss_out;
    __device__ __forceinline__ void operator()(const f32x4 (&acc)[2][2][4][2], const Unit& u, int wr, int wc, int fr, int fq) const {
        const int row0 = u.pm * BM + wr * 64 + fr, col0 = u.pn * BM + wc * 32 + 8 * fq;
        bf16_t* base = X + (size_t)row0 * DM + col0;
        u32x4 xw[2][4][2];
#pragma unroll
        for (int ai = 0; ai < 2; ++ai)
#pragma unroll
            for (int m = 0; m < 4; ++m)
#pragma unroll
                for (int bj = 0; bj < 2; ++bj) xw[ai][m][bj] = *(const u32x4*)(base + (size_t)(ai * HALF + m * 16) * DM + bj * HALF);
#pragma unroll
        for (int ai = 0; ai < 2; ++ai)
#pragma unroll
            for (int m = 0; m < 4; ++m) { const int row = row0 + ai * HALF + m * 16; bf16_t* rowp = base + (size_t)(ai * HALF + m * 16) * DM; float s = 0.f;
#pragma unroll
                for (int bj = 0; bj < 2; ++bj) { const u32x4 w_ = xw[ai][m][bj]; f32x4 v0 = acc[ai][bj][m][0], v1 = acc[ai][bj][m][1];
                    v0[0] += bflo(w_.x); v0[1] += bfhi(w_.x); v0[2] += bflo(w_.y); v0[3] += bfhi(w_.y); v1[0] += bflo(w_.z); v1[1] += bfhi(w_.z); v1[2] += bflo(w_.w); v1[3] += bfhi(w_.w);
                    s += ((v0[0] * v0[0] + v0[1] * v0[1]) + (v0[2] * v0[2] + v0[3] * v0[3])) + ((v1[0] * v1[0] + v1[1] * v1[1]) + (v1[2] * v1[2] + v1[3] * v1[3]));
                    u32x4 w; w.x = cvt_pk_bf16(v0[0], v0[1]); w.y = cvt_pk_bf16(v0[2], v0[3]); w.z = cvt_pk_bf16(v1[0], v1[1]); w.w = cvt_pk_bf16(v1[2], v1[3]);
                    *(u32x4*)(rowp + bj * HALF) = w; }
                s += __shfl_xor(s, 16); s += __shfl_xor(s, 32);
                if (fq == 0) ss_out[(size_t)row * 16 + u.pn * 4 + wc] = s; }
    }
};

struct EpiGU {
    bf16_t* H; const float* ss;
    __device__ __forceinline__ void operator()(const f32x4 (&acc)[2][2][4][2], const Unit& u, int wr, int wc, int fr, int fq) const {
        const int row0 = u.pm * BM + wr * 64 + fr, col0 = u.pn * HALF + wc * 32 + 8 * fq;
        float rs8[8]; rows_rstd8(ss, row0, fq * 16 + fr, rs8);
#pragma unroll
        for (int ai = 0; ai < 2; ++ai)
#pragma unroll
            for (int m = 0; m < 4; ++m) { const int row = row0 + ai * HALF + m * 16; const float rs = rs8[ai * 4 + m];
                float h[8];
#pragma unroll
                for (int n = 0; n < 2; ++n)
#pragma unroll
                    for (int i = 0; i < 4; ++i) { const float gg = acc[ai][0][m][n][i] * rs, uu = acc[ai][1][m][n][i] * rs;
                        h[4 * n + i] = gg * uu * __builtin_amdgcn_rcpf(1.0f + __builtin_amdgcn_exp2f(-gg * LOG2E)); }
                u32x4 w; w.x = cvt_pk_bf16(h[0], h[1]); w.y = cvt_pk_bf16(h[2], h[3]); w.z = cvt_pk_bf16(h[4], h[5]); w.w = cvt_pk_bf16(h[6], h[7]);
                *(u32x4*)(H + (size_t)row * FFN + col0) = w; }
    }
};

template <bool LAST> struct EpiPLE {
    const bf16_t* Xin; bf16_t* Xout; const bf16_t* PP; const float* ss; float* ss_out; float* out;
    __device__ __forceinline__ void operator()(const f32x4 (&acc)[2][2][4][2], const Unit& u, int wr, int wc, int fr, int fq) const {
        const int row0 = u.pm * BM + wr * 64 + fr, col0 = u.pn * BM + wc * 32 + 8 * fq;
        float rs8[8]; rows_rstd8(ss, row0, fq * 16 + fr, rs8);
#pragma unroll
        for (int ai = 0; ai < 2; ++ai) {
            u32x4 xw[4][2], pw[4][2];
#pragma unroll
            for (int m = 0; m < 4; ++m)
#pragma unroll
                for (int bj = 0; bj < 2; ++bj) { const size_t off = (size_t)(row0 + ai * HALF + m * 16) * DM + col0 + bj * HALF; xw[m][bj] = *(const u32x4*)(Xin + off); pw[m][bj] = *(const u32x4*)(PP + off); }
            asm volatile("" ::: "memory");
#pragma unroll
            for (int m = 0; m < 4; ++m) { const int row = row0 + ai * HALF + m * 16; const float rs = rs8[ai * 4 + m]; const size_t off = (size_t)row * DM + col0; float s = 0.f;
#pragma unroll
                for (int bj = 0; bj < 2; ++bj) { const u32x4 xq_ = xw[m][bj], pq_ = pw[m][bj];
                    float xv[8] = {bflo(xq_.x), bfhi(xq_.x), bflo(xq_.y), bfhi(xq_.y), bflo(xq_.z), bfhi(xq_.z), bflo(xq_.w), bfhi(xq_.w)};
                    const float pv[8] = {bflo(pq_.x), bfhi(pq_.x), bflo(pq_.y), bfhi(pq_.y), bflo(pq_.z), bfhi(pq_.z), bflo(pq_.w), bfhi(pq_.w)};
#pragma unroll
                    for (int n = 0; n < 2; ++n)
#pragma unroll
                        for (int i = 0; i < 4; ++i) { const float a = acc[ai][bj][m][n][i] * rs; const float gate = __builtin_amdgcn_rcpf(1.0f + __builtin_amdgcn_exp2f(-a * LOG2E));
                            xv[4 * n + i] += gate * pv[4 * n + i]; s += xv[4 * n + i] * xv[4 * n + i]; }
                    if (LAST) { *(f32x4*)(out + off + bj * HALF) = (f32x4){xv[0], xv[1], xv[2], xv[3]}; *(f32x4*)(out + off + bj * HALF + 4) = (f32x4){xv[4], xv[5], xv[6], xv[7]}; }
                    else { u32x4 w; w.x = cvt_pk_bf16(xv[0], xv[1]); w.y = cvt_pk_bf16(xv[2], xv[3]); w.z = cvt_pk_bf16(xv[4], xv[5]); w.w = cvt_pk_bf16(xv[6], xv[7]); *(u32x4*)(Xout + off + bj * HALF) = w; } }
                if (!LAST) { s += __shfl_xor(s, 16); s += __shfl_xor(s, 32); if (fq == 0) ss_out[(size_t)row * 16 + u.pn * 4 + wc] = s; } }
        }
    }
};
}

struct AttnP { const bf16_t* Q; bf16_t* O; const bf16_t* Kb; const bf16_t* Vb; float* LSE; const float* sink; const float* qg; const float* kg; };
__device__ __forceinline__ float xhalf_max(float m) { auto rr = __builtin_amdgcn_permlane32_swap(__float_as_uint(m), __float_as_uint(m), false, false); return fmaxf(__uint_as_float(rr[0]), __uint_as_float(rr[1])); }
__device__ __forceinline__ float xhalf_sum(float m) { auto rr = __builtin_amdgcn_permlane32_swap(__float_as_uint(m), __float_as_uint(m), false, false); return __uint_as_float(rr[0]) + __uint_as_float(rr[1]); }

template <bool LB>
__device__ __forceinline__ void attn_phase(const AttnP P, LAS unsigned char* lds, int vcu, int G, int wave, int lane) {
    constexpr int R = LB ? 64 : 128, NT = 2 * R / 32 + 1, TD = R / 32, HPT = LB ? 1 : 2, WPS = LB ? 4 : 8, NR = LB ? 3 : 1;
    constexpr int W = 128 + 2 * R, KP = 144, VPB = (W + 8) * 2, SUBB = W * KP + 64 * VPB;
    constexpr int NBT = LB ? 2304 : 3072;
    constexpr int LDQ = (LB ? B_NQ : A_NQ) * 64, LDK = (LB ? B_NKV : A_NKV) * 64;
    static_assert((8 / WPS) * SUBB <= 147456, "attention LDS");
    const int NI = (NBT + G - 1) / G;
    const int q = lane & 31, hi = lane >> 5;
    const int sub = wave / WPS, wsub = wave % WPS;
    const float xq = (float)(4 * hi - q);
    float bnd; { float gq = fabsf(P.qg[lane]), gk = fabsf(P.kg[lane]);
#pragma unroll
        for (int o = 1; o < 64; o <<= 1) { gq = fmaxf(gq, __shfl_xor(gq, o)); gk = fmaxf(gk, __shfl_xor(gk, o)); }
        bnd = 8.0f * LOG2E * 1.02f * gq * gk; }
    const int vro0 = q * VPB, vro1 = (32 + q) * VPB, dsw0 = q & ~7, dsw1 = 32 + (q & ~7);
#pragma unroll 1
    for (int it = 0; it < NI; ++it) {
        const int bt = it * G + vcu; if (bt >= NBT) break;
        const int st = LB ? bt * 2 + sub : bt;
        int hq0, kvh, ld, blk;
        if (LB) { const int kvc = st & 1, tb = st >> 1, g = tb / 768; blk = tb - g * 768; kvh = 2 * g + kvc; hq0 = 6 * g; ld = 2 * g; }
        else { kvh = st & 3; blk = st >> 2; hq0 = kvh * 4; ld = 0; }
        int sb, lsh, w;
        if (blk < 512) { lsh = 13; sb = (blk >> 6) << 13; w = blk & 63; } else { const int bb = blk - 512; lsh = 11; sb = MPROMPT + ((bb >> 4) << 11); w = bb & 15; }
        const int lrs = lsh - ld;
        const int Lr = 1 << lrs, res = w >> (lrs - 7), i0b = (w & ((1 << (lrs - 7)) - 1)) << 7;
        {
            LAS unsigned char* Ks = lds + sub * SUBB; LAS unsigned char* Vs = Ks + W * KP;
            const int ws0 = i0b - R, c = lane & 7;
            const bf16_t* kg = P.Kb + ((size_t)sb + res) * LDK + kvh * 64 + 8 * c;
            const bf16_t* vg = P.Vb + ((size_t)sb + res) * LDK + kvh * 64 + 8 * c;
            constexpr int NSTG = W / (8 * WPS);
            u32x4 kv[NSTG], vv[NSTG];
#pragma unroll
            for (int k = 0; k < NSTG; ++k) {
                const int p = 8 * (k * WPS + wsub) + (lane >> 3); int kj = ws0 + p; kj = kj < 0 ? 0 : kj; kj = kj >= Lr ? Lr - 1 : kj;
                const size_t ro = ((size_t)kj << ld) * LDK;
                kv[k] = *(const u32x4*)(kg + ro); vv[k] = *(const u32x4*)(vg + ro);
            }
#pragma unroll
            for (int k = 0; k < NSTG; ++k) {
                const int p = 8 * (k * WPS + wsub) + (lane >> 3);
                *(LAS u32x4*)(Ks + p * KP + c * 16) = kv[k];
                const int pp = (p & ~12) | ((p & 4) << 1) | ((p & 8) >> 1);
                LAS unsigned short* vp = (LAS unsigned short*)(Vs + (8 * c) * VPB + ((pp ^ (c << 3)) * 2));
                vp[0] = (unsigned short)(vv[k].x & 0xffffu); vp[VPB / 2] = (unsigned short)(vv[k].x >> 16); vp[2 * (VPB / 2)] = (unsigned short)(vv[k].y & 0xffffu); vp[3 * (VPB / 2)] = (unsigned short)(vv[k].y >> 16);
                vp[4 * (VPB / 2)] = (unsigned short)(vv[k].z & 0xffffu); vp[5 * (VPB / 2)] = (unsigned short)(vv[k].z >> 16); vp[6 * (VPB / 2)] = (unsigned short)(vv[k].w & 0xffffu); vp[7 * (VPB / 2)] = (unsigned short)(vv[k].w >> 16);
            }
        }
        bf16x8 qfr[NR][HPT][4];
#pragma unroll
        for (int rd = 0; rd < NR; ++rd) {
            int qtile, hqr;
            if (LB) { const int j = rd * 8 + wave; const int cs = j >= 12 ? 1 : 0; const int rem = j - 12 * cs; qtile = rem & 3; hqr = hq0 + 3 * cs + (rem >> 2); }
            else { qtile = wave & 3; hqr = hq0 + 2 * (wave >> 2); }
            const unsigned rowq_ = (unsigned)sb + ((unsigned)(i0b + 32 * qtile + q) << ld) + res;
            const char* Qp_ = (const char*)(P.Q + hqr * 64) + (rowq_ * LDQ + 4 * hi) * 2u + 8 * hi;
#pragma unroll
            for (int h = 0; h < HPT; ++h)
#pragma unroll
                for (int s = 0; s < 4; ++s) qfr[rd][h][s] = *(const bf16x8*)(Qp_ + (h * 64 + 16 * s) * 2);
        }
        __syncthreads();
#pragma unroll
        for (int rd = 0; rd < NR; ++rd) {
        int csub, qtile, hqr;
        if (LB) { const int j = rd * 8 + wave; csub = j >= 12 ? 1 : 0; const int rem = j - 12 * csub; qtile = rem & 3; hqr = hq0 + 3 * csub + (rem >> 2); }
        else { csub = 0; qtile = wave & 3; hqr = hq0 + 2 * (wave >> 2); }
        const LAS unsigned char* Ks = lds + csub * SUBB; const LAS unsigned char* Vs = Ks + W * KP;
        const int i0 = i0b + 32 * qtile, kro = (32 * qtile + q) * KP + 16 * hi, pos0 = 32 * qtile + 8 * hi;
        const unsigned rowq = (unsigned)sb + ((unsigned)(i0 + q) << ld) + res;
        const unsigned qoff = (rowq * LDQ + 4 * hi) * 2u;
        bf16x8 qf[HPT][4]; float l[HPT], nslope2[HPT]; f32x16 o0[HPT], o1[HPT];
#pragma unroll
        for (int h = 0; h < HPT; ++h) {
#pragma unroll
            for (int s = 0; s < 4; ++s) qf[h][s] = qfr[rd][h][s];
            if (LB) { l[h] = 0.f; } else { l[h] = hi == 0 ? __builtin_amdgcn_exp2f(P.sink[hqr + h] * LOG2E - bnd) : 0.f; }
            nslope2[h] = -exp2f(-8.0f * (float)(hqr + h + 1) / (float)(LB ? B_NQ : A_NQ)) * (float)(1 << ld) * LOG2E;
#pragma unroll
            for (int r = 0; r < 16; ++r) { o0[h][r] = 0.f; o1[h][r] = 0.f; }
        }
        int t_lo = (R - i0) >> 5; if (t_lo < 0) t_lo = 0;
        int t_hi = (Lr - i0 + R) >> 5; if (t_hi > NT) t_hi = NT;
#pragma unroll 1
        for (int i = 0; i < NT; ++i) {
            const int t = TD + ((i & 1) ? -((i + 1) >> 1) : (i >> 1));
            if (t < t_lo || t >= t_hi) continue;
            bf16x8 kf[4], vf[2][2];
#pragma unroll
            for (int s = 0; s < 4; ++s) kf[s] = *(const LAS bf16x8*)(Ks + kro + t * (32 * KP) + 32 * s);
#pragma unroll
            for (int s = 0; s < 2; ++s) { const int pos = pos0 + 32 * t + 16 * s;
                vf[s][0] = *(const LAS bf16x8*)(Vs + vro0 + ((pos ^ dsw0) * 2)); vf[s][1] = *(const LAS bf16x8*)(Vs + vro1 + ((pos ^ dsw1) * 2)); }
            const bool edge = (t == 0) || (t == NT - 1);
            const float xb_ = xq + (float)(32 * t - R);
#pragma unroll
            for (int h = 0; h < HPT; ++h) {
                f32x16 S;
                if (edge || t == TD) {
#pragma unroll
                    for (int r = 0; r < 16; ++r) { const float x = __builtin_fabsf(xb_ + (float)((r & 3) + 8 * (r >> 2))); float c = fmaf(nslope2[h], x, -bnd); if (edge && x > (float)R) c = -INFINITY; S[r] = c; }
                } else {
                    const float sg = t > TD ? nslope2[h] : -nslope2[h]; const float a0 = fmaf(sg, xb_, -bnd);
#pragma unroll
                    for (int r = 0; r < 16; ++r) S[r] = fmaf(sg, (float)((r & 3) + 8 * (r >> 2)), a0);
                }
#pragma unroll
                for (int s = 0; s < 4; ++s) S = __builtin_amdgcn_mfma_f32_32x32x16_bf16(kf[s], qf[h][s], S, 0, 0, 0);
                float ps = 0.f;
#pragma unroll
                for (int r = 0; r < 16; ++r) { const float p = __builtin_amdgcn_exp2f(S[r]); S[r] = p; ps += p; }
                l[h] += ps;
                u32x4 w0, w1;
                w0.x = cvt_pk_bf16(S[0], S[1]); w0.y = cvt_pk_bf16(S[2], S[3]); w0.z = cvt_pk_bf16(S[4], S[5]); w0.w = cvt_pk_bf16(S[6], S[7]);
                w1.x = cvt_pk_bf16(S[8], S[9]); w1.y = cvt_pk_bf16(S[10], S[11]); w1.z = cvt_pk_bf16(S[12], S[13]); w1.w = cvt_pk_bf16(S[14], S[15]);
                const bf16x8 pf0 = __builtin_bit_cast(bf16x8, w0), pf1 = __builtin_bit_cast(bf16x8, w1);
                o0[h] = __builtin_amdgcn_mfma_f32_32x32x16_bf16(vf[0][0], pf0, o0[h], 0, 0, 0);
                o1[h] = __builtin_amdgcn_mfma_f32_32x32x16_bf16(vf[0][1], pf0, o1[h], 0, 0, 0);
                o0[h] = __builtin_amdgcn_mfma_f32_32x32x16_bf16(vf[1][0], pf1, o0[h], 0, 0, 0);
                o1[h] = __builtin_amdgcn_mfma_f32_32x32x16_bf16(vf[1][1], pf1, o1[h], 0, 0, 0);
            }
        }
#pragma unroll
        for (int h = 0; h < HPT; ++h) {
            const float lt = xhalf_sum(l[h]);
            const float inv = 1.0f / lt;
            char* Op = (char*)(P.O + (hqr + h) * 64) + (qoff - 8u * hi) + 16u * hi;
#pragma unroll
            for (int pr = 0; pr < 2; ++pr) {
                const int a0 = 2 * pr, a1 = 2 * pr + 1;
                const unsigned Ax0 = cvt_pk_bf16(o0[h][4 * a0] * inv, o0[h][4 * a0 + 1] * inv), Ay0 = cvt_pk_bf16(o0[h][4 * a0 + 2] * inv, o0[h][4 * a0 + 3] * inv);
                const unsigned Bx0 = cvt_pk_bf16(o0[h][4 * a1] * inv, o0[h][4 * a1 + 1] * inv), By0 = cvt_pk_bf16(o0[h][4 * a1 + 2] * inv, o0[h][4 * a1 + 3] * inv);
                const unsigned Ax1 = cvt_pk_bf16(o1[h][4 * a0] * inv, o1[h][4 * a0 + 1] * inv), Ay1 = cvt_pk_bf16(o1[h][4 * a0 + 2] * inv, o1[h][4 * a0 + 3] * inv);
                const unsigned Bx1 = cvt_pk_bf16(o1[h][4 * a1] * inv, o1[h][4 * a1 + 1] * inv), By1 = cvt_pk_bf16(o1[h][4 * a1 + 2] * inv, o1[h][4 * a1 + 3] * inv);
                const auto sx0 = __builtin_amdgcn_permlane32_swap(Ax0, Bx0, false, false), sy0 = __builtin_amdgcn_permlane32_swap(Ay0, By0, false, false);
                const auto sx1 = __builtin_amdgcn_permlane32_swap(Ax1, Bx1, false, false), sy1 = __builtin_amdgcn_permlane32_swap(Ay1, By1, false, false);
                u32x4 w0, w1; w0.x = sx0[0]; w0.y = sy0[0]; w0.z = sx0[1]; w0.w = sy0[1]; w1.x = sx1[0]; w1.y = sy1[0]; w1.z = sx1[1]; w1.w = sy1[1];
                *(u32x4*)(Op + 32 * pr) = w0; *(u32x4*)(Op + 64 + 32 * pr) = w1;
            }
            if (LB) { if (hi == 0) *(float*)((char*)(P.LSE + hqr + h) + rowq * (B_NQ * 4)) = bnd + log2f(lt); }
        }
        }
        __syncthreads();
    }
}

__device__ __forceinline__ void combine_phase(bf16_t* O, const float* LSE, int gw, int ngw, int lane) {
    int idx[3], g[3], j[3];
#pragma unroll
    for (int i = 0; i < 3; ++i) { idx[i] = lane + 64 * i; const int head = (idx[i] < 144 ? idx[i] : 0) >> 3; g[i] = head / 6; j[i] = head - 6 * g[i]; }
#pragma unroll 1
    for (int row0 = MTOT - 4 - gw * 4; row0 >= 0; row0 -= ngw * 4) {
        u32x4 w[4][3]; float al[4][3];
#pragma unroll
        for (int r = 0; r < 4; ++r) { const bf16_t* rp = O + (size_t)(row0 + r) * (B_NQ * 64);
#pragma unroll
            for (int i = 0; i < 3; ++i) if (i < 2 || idx[i] < 144) w[r][i] = *(const u32x4*)(rp + 8 * idx[i]); }
#pragma unroll
        for (int r = 0; r < 4; ++r) { const float* lp = LSE + (size_t)(row0 + r) * B_NQ;
#pragma unroll
            for (int i = 0; i < 3; ++i) { const float l0 = lp[j[i]], l1 = lp[6 + j[i]], l2 = lp[12 + j[i]]; const float mx = fmaxf(l0, fmaxf(l1, l2));
                const float e0 = __builtin_amdgcn_exp2f(l0 - mx), e1 = __builtin_amdgcn_exp2f(l1 - mx), e2 = __builtin_amdgcn_exp2f(l2 - mx);
                al[r][i] = (g[i] == 0 ? e0 : (g[i] == 1 ? e1 : e2)) / (e0 + e1 + e2); } }
#pragma unroll
        for (int r = 0; r < 4; ++r) { bf16_t* rp = O + (size_t)(row0 + r) * (B_NQ * 64);
#pragma unroll
            for (int i = 0; i < 3; ++i) if (i < 2 || idx[i] < 144) { u32x4 v = w[r][i]; const float a_ = al[r][i];
                v.x = cvt_pk_bf16(bflo(v.x) * a_, bfhi(v.x) * a_); v.y = cvt_pk_bf16(bflo(v.y) * a_, bfhi(v.y) * a_); v.z = cvt_pk_bf16(bflo(v.z) * a_, bfhi(v.z) * a_); v.w = cvt_pk_bf16(bflo(v.w) * a_, bfhi(v.w) * a_);
                *(u32x4*)(rp + 8 * idx[i]) = v; } }
    }
}

__device__ __forceinline__ void p0_item(const float* W0, const float* W1, int K, int Nsrc, bf16_t* WT, int mode, const float* gain, LAS float* scr, int item, int nsg, int lane) {
    const int kb = item / nsg, sg = item - kb * nsg, k0 = 64 * kb, s0 = 32 * sg;
    const float* W = W0; int c0 = s0; bool valid = true;
    if (mode == 1) { const int pn = s0 >> 8, bj = (s0 >> 7) & 1, wc = (s0 >> 5) & 3; c0 = pn * 256 + wc * 64 + bj * 32; valid = c0 < Nsrc; }
    else if (mode == 2) { const int pn = s0 >> 8, bj = (s0 >> 7) & 1, wc = (s0 >> 5) & 3; c0 = pn * 128 + wc * 32; W = bj ? W1 : W0; }
#pragma unroll 8
    for (int i = 0; i < 32; ++i) { const int kk = 2 * i + (lane >> 5); float v = 0.f;
        if (valid) { v = W[(size_t)(k0 + kk) * Nsrc + c0 + (lane & 31)]; if (gain) v *= gain[k0 + kk]; }
        scr[kk * 33 + (lane & 31)] = v; }
    asm volatile("s_waitcnt lgkmcnt(0)" ::: "memory");
    const int c = lane & 7;
#pragma unroll
    for (int j = 0; j < 4; ++j) { const int n = (lane >> 3) + 8 * j; const LAS float* s = scr + (8 * c) * 33 + n;
        u32x4 o; o.x = cvt_pk_bf16(s[0 * 33], s[1 * 33]); o.y = cvt_pk_bf16(s[2 * 33], s[3 * 33]); o.z = cvt_pk_bf16(s[4 * 33], s[5 * 33]); o.w = cvt_pk_bf16(s[6 * 33], s[7 * 33]);
        *(u32x4*)(WT + (size_t)(s0 + n) * K + k0 + 8 * c) = o; }
    asm volatile("s_waitcnt lgkmcnt(0)" ::: "memory");
}

constexpr size_t MiB = 1u << 20;
constexpr size_t W_QKVA = 0, W_QKVB = W_QKVA + (size_t)1536 * 1024 * 2, W_OA = W_QKVB + (size_t)2048 * 1024 * 2, W_OB = W_OA + (size_t)1024 * 1024 * 2,
                 W_GU = W_OB + (size_t)1024 * 1152 * 2, W_DN = W_GU + (size_t)2 * 5632 * 1024 * 2, W_PG = W_DN + (size_t)2 * 1024 * 2816 * 2, W_PP = W_PG + (size_t)2 * 1024 * 1024 * 2,
                 W_END = W_PP + (size_t)2 * 1024 * 256 * 2;
static_assert(W_END <= 56 * MiB, "weights region");
constexpr size_t WS_SSA = 56 * MiB, WS_SSB = 64 * MiB;
constexpr size_t WS_BAR = 62 * MiB, WS_BAR_BYTES = 16384;
constexpr size_t WS_XBB = 72 * MiB;
constexpr size_t WS_PPJ = 264 * MiB;
constexpr size_t WS_BIG = 456 * MiB;
constexpr size_t BIG_Q = 0, BIG_K = 216 * MiB, BIG_VT = 288 * MiB, BIG_LSE = 362 * MiB;
constexpr size_t WS_END = WS_BIG + 528 * MiB;
constexpr size_t OUT_XBA = 0, OUT_PB = 192 * MiB;

constexpr int LDS_BYTES = 147456;
constexpr int NPHASE = 14;

struct Args {
    const float* in[21]; float* out; unsigned char* ws; int ph_lo, ph_hi;
};

#define XB_TMO      128
#define XB_XCNT(j)  (256  + 64 * (j))
#define XB_XSUB(j)  (1280 + 64 * (j))
#define XB_XGEN(j)  (2304 + 64 * (j))
#define XB_TOP      3328
#define XB_TOPGEN   3392
#define XCD_BAR_WORDS 3456
#define XB_SPIN_CAP (1u << 24)
__device__ __forceinline__ unsigned xb_ld(unsigned* p)              { return __hip_atomic_load(p, __ATOMIC_RELAXED, __HIP_MEMORY_SCOPE_AGENT); }
__device__ __forceinline__ unsigned xb_add(unsigned* p, unsigned v) { return __hip_atomic_fetch_add(p, v, __ATOMIC_RELAXED, __HIP_MEMORY_SCOPE_AGENT); }
__device__ __forceinline__ unsigned xb_xcc_id() { return (unsigned)__builtin_amdgcn_s_getreg((3 << 11) | 20) & 0xFu; }
#define XB_SPIN(cond, bar) do { unsigned _sp = 0; while (cond) { __builtin_amdgcn_s_sleep(1); \
    if ((++_sp & 255u) == 0u) { if (xb_ld(&(bar)[XB_TMO])) break; if (_sp > XB_SPIN_CAP) { atomicAdd(&(bar)[XB_TMO], 1u); break; } } } } while (0)
struct XcdBarrier { unsigned* bar; unsigned x; volatile LAS unsigned* st; };
__device__ __forceinline__ XcdBarrier xcd_barrier_post(unsigned* bar, volatile LAS unsigned* st) {
    XcdBarrier b; b.bar = bar; b.x = xb_xcc_id(); b.st = st;
    if (threadIdx.x == 0) (void)xb_add(&bar[XB_XCNT(b.x)], 1u);
    return b;
}
__device__ __forceinline__ void xcd_barrier_complete(unsigned* bar, unsigned x, unsigned& nloc, unsigned& nx) {
    const unsigned G = gridDim.x * gridDim.y * gridDim.z;
    unsigned sum, cnt, mine, sp = 0u;
    for (;;) {
        sum = 0u; cnt = 0u; mine = 0u;
#pragma unroll
        for (unsigned j = 0; j < 16; ++j) { const unsigned c = xb_ld(&bar[XB_XCNT(j)]); sum += c; cnt += (c > 0u) ? 1u : 0u; mine = (j == x) ? c : mine; }
        if (sum == G) break;
        __builtin_amdgcn_s_sleep(1);
        if ((++sp & 255u) == 0u) { if (xb_ld(&bar[XB_TMO])) break; if (sp > XB_SPIN_CAP) { atomicAdd(&bar[XB_TMO], 1u); break; } }
    }
    nloc = mine > 0u ? mine : 1u; nx = cnt > 0u ? cnt : 1u;
}
__device__ __forceinline__ void xcd_barrier(const XcdBarrier& b) {
    asm volatile("s_waitcnt vmcnt(0)" ::: "memory");
    __syncthreads();
    if (threadIdx.x == 0) {
        unsigned* bar = b.bar;
        __builtin_amdgcn_s_waitcnt(0);
        unsigned nloc = b.st[0], nx = b.st[1];
        if (nloc == 0u) { xcd_barrier_complete(bar, b.x, nloc, nx); b.st[0] = nloc; b.st[1] = nx; }
        const unsigned old = xb_add(&bar[XB_XSUB(b.x)], 1u);
        const unsigned gen = old / nloc;
        if (old + 1u == (gen + 1u) * nloc) {
            __builtin_amdgcn_fence(__ATOMIC_RELEASE, "agent");
            asm volatile("s_waitcnt vmcnt(0)" ::: "memory");
            const unsigned og = xb_add(&bar[XB_TOP], 1u);
            const unsigned tg = og / nx;
            if (og + 1u == (tg + 1u) * nx) xb_add(&bar[XB_TOPGEN], 1u);
            else XB_SPIN(xb_ld(&bar[XB_TOPGEN]) == tg, bar);
            __builtin_amdgcn_fence(__ATOMIC_ACQUIRE, "agent");
            xb_add(&bar[XB_XGEN(b.x)], 1u);
            asm volatile("s_waitcnt vmcnt(0)" ::: "memory");
        } else {
            XB_SPIN(xb_ld(&bar[XB_XGEN(b.x)]) == gen, bar);
            __builtin_amdgcn_fence(__ATOMIC_ACQUIRE, "agent");
            asm volatile("s_waitcnt vmcnt(0)" ::: "memory");
        }
    }
    __syncthreads();
}

#define WSP(T, off) ((T*)(ws + (off)))
template <int LAYER>
__device__ __forceinline__ void run_layer(const Args& args, LAS unsigned char* lds, const XcdBarrier& xbar, int lo, int hi) {
#define IN(k) (lo <= (k) && (k) < hi)
#define SEAM(k) do { if (IN(k) && IN((k) + 1)) xcd_barrier(xbar); } while (0)
    constexpr int pb0 = 1 + LAYER * 6;
    constexpr size_t XCUR_IS_OUT = LAYER == 0;
    if (IN(pb0)) {
        unsigned char* ws = args.ws; asm volatile("" : "+s"(ws));
        const int G = gridDim.x, bx = blockIdx.x;
        bf16_t* xcur = LAYER == 0 ? (bf16_t*)((unsigned char*)args.out + OUT_XBA) : WSP(bf16_t, WS_XBB);
        const float* ss_mix = LAYER == 0 ? WSP(float, WS_SSA) : WSP(float, WS_SSB);
        pg8::StaticOrder S;
        if (LAYER == 0) { pg8::Gemm g{xcur, WSP(bf16_t, W_QKVA), MTOT, 1536, 1024}; S.init(MTOT, 1536, G, bx, 1);
            pg8::EpiQKV<false> E{WSP(bf16_t, WS_BIG + BIG_Q), WSP(bf16_t, WS_BIG + BIG_K), WSP(bf16_t, WS_BIG + BIG_VT), ss_mix, args.in[9], args.in[10]}; pg8::gemm_phase(lds, g, S, E); }
        else { pg8::Gemm g{xcur, WSP(bf16_t, W_QKVB), MTOT, 2048, 1024}; S.init(MTOT, 2048, G, bx, 1);
            pg8::EpiQKV<true> E{WSP(bf16_t, WS_BIG + BIG_Q), WSP(bf16_t, WS_BIG + BIG_K), WSP(bf16_t, WS_BIG + BIG_VT), ss_mix, args.in[14], args.in[15]}; pg8::gemm_phase(lds, g, S, E); }
        { const bf16_t* pb = (const bf16_t*)((unsigned char*)args.out + OUT_PB) + (size_t)LAYER * MTOT * PLE;
            pg8::Gemm g{pb, WSP(bf16_t, W_PP) + (size_t)LAYER * 1024 * 256, MTOT, 1024, 256}; S.init(MTOT, 1024, G, bx);
            pg8::EpiPlain E{WSP(bf16_t, WS_PPJ), DM}; pg8::gemm_phase(lds, g, S, E); }
    }
    SEAM(pb0);
    if (IN(pb0 + 1)) {
        unsigned char* ws = args.ws; asm volatile("" : "+s"(ws));
        int tid = threadIdx.x; asm volatile("" : "+v"(tid));
        const int lane = tid & 63, wave = __builtin_amdgcn_readfirstlane(tid >> 6);
        const int G = gridDim.x, bx = blockIdx.x, vcu = (G % 8 == 0) ? (bx % 8) * (G / 8) + bx / 8 : bx;
        bf16_t* Obuf = LAYER == 0 ? WSP(bf16_t, WS_XBB) : (bf16_t*)((unsigned char*)args.out + OUT_XBA);
        AttnP P{WSP(bf16_t, WS_BIG + BIG_Q), Obuf, WSP(bf16_t, WS_BIG + BIG_K), WSP(bf16_t, WS_BIG + BIG_VT), WSP(float, WS_BIG + BIG_LSE), args.in[11], LAYER == 0 ? args.in[9] : args.in[14], LAYER == 0 ? args.in[10] : args.in[15]};
        attn_phase<LAYER == 1>(P, lds, vcu, G, wave, lane);
#if defined(PROBE_DUP_ATTN)
        attn_phase<LAYER == 1>(P, lds, vcu, G, wave, lane);
#endif
        __syncthreads();
    }
    SEAM(pb0 + 1);
    constexpr int pw = pb0 + 2 + LAYER;
    if (LAYER == 1) {
        if (IN(pb0 + 2)) {
            unsigned char* ws = args.ws; asm volatile("" : "+s"(ws));
            int tid = threadIdx.x; asm volatile("" : "+v"(tid));
            const int lane = tid & 63, wave = __builtin_amdgcn_readfirstlane(tid >> 6);
            const int G = gridDim.x, bx = blockIdx.x, vcu = (G % 8 == 0) ? (bx % 8) * (G / 8) + bx / 8 : bx;
            combine_phase((bf16_t*)((unsigned char*)args.out + OUT_XBA), WSP(float, WS_BIG + BIG_LSE), vcu * 8 + wave, G * 8, lane); __syncthreads(); }
        SEAM(pb0 + 2);
    }
    if (IN(pw)) {
        unsigned char* ws = args.ws; asm volatile("" : "+s"(ws));
        const int G = gridDim.x, bx = blockIdx.x;
        bf16_t* xcur = LAYER == 0 ? (bf16_t*)((unsigned char*)args.out + OUT_XBA) : WSP(bf16_t, WS_XBB);
        float* ss_ffn = LAYER == 0 ? WSP(float, WS_SSB) : WSP(float, WS_SSA);
        pg8::StaticOrder S; S.init(MTOT, 1024, G, bx, LAYER == 0 ? 1 : 0);
        pg8::Gemm g{LAYER == 0 ? WSP(bf16_t, WS_XBB) : (bf16_t*)((unsigned char*)args.out + OUT_XBA), LAYER == 0 ? WSP(bf16_t, W_OA) : WSP(bf16_t, W_OB), MTOT, 1024, LAYER == 0 ? 1024 : 1152};
        pg8::EpiResid E{xcur, ss_ffn}; pg8::gemm_phase(lds, g, S, E);
    }
    SEAM(pw);
    if (IN(pw + 1)) {
        unsigned char* ws = args.ws; asm volatile("" : "+s"(ws));
        const int G = gridDim.x, bx = blockIdx.x;
        bf16_t* xcur = LAYER == 0 ? (bf16_t*)((unsigned char*)args.out + OUT_XBA) : WSP(bf16_t, WS_XBB);
        const float* ss_ffn = LAYER == 0 ? WSP(float, WS_SSB) : WSP(float, WS_SSA);
        pg8::StaticOrder S; S.init(MTOT, 5632, G, bx, LAYER == 0 ? 0 : 1);
        pg8::Gemm g{xcur, WSP(bf16_t, W_GU) + (size_t)LAYER * 5632 * 1024, MTOT, 5632, 1024};
        pg8::EpiGU E{WSP(bf16_t, WS_BIG), ss_ffn}; pg8::gemm_phase(lds, g, S, E);
#if defined(PROBE_DUP_GU0)
        if (LAYER == 0) { pg8::gemm_phase(lds, g, S, E); }
#endif
    }
    SEAM(pw + 1);
    if (IN(pw + 2)) {
        unsigned char* ws = args.ws; asm volatile("" : "+s"(ws));
        const int G = gridDim.x, bx = blockIdx.x;
        bf16_t* xcur = LAYER == 0 ? (bf16_t*)((unsigned char*)args.out + OUT_XBA) : WSP(bf16_t, WS_XBB);
        float* ss_ple = LAYER == 0 ? WSP(float, WS_SSA) : WSP(float, WS_SSB);
        pg8::StaticOrder S; S.init(MTOT, 1024, G, bx, LAYER == 0 ? 1 : 0);
        pg8::Gemm g{WSP(bf16_t, WS_BIG), WSP(bf16_t, W_DN) + (size_t)LAYER * 1024 * FFN, MTOT, 1024, FFN};
        pg8::EpiResid E{xcur, ss_ple}; pg8::gemm_phase(lds, g, S, E);
    }
    SEAM(pw + 2);
    if (IN(pw + 3)) {
        unsigned char* ws = args.ws; asm volatile("" : "+s"(ws));
        const int G = gridDim.x, bx = blockIdx.x;
        bf16_t* xcur = LAYER == 0 ? (bf16_t*)((unsigned char*)args.out + OUT_XBA) : WSP(bf16_t, WS_XBB);
        const float* ss_ple = LAYER == 0 ? WSP(float, WS_SSA) : WSP(float, WS_SSB);
        pg8::StaticOrder S; S.init(MTOT, 1024, G, bx, LAYER == 0 ? 0 : 1);
        pg8::Gemm g{xcur, WSP(bf16_t, W_PG) + (size_t)LAYER * 1024 * 1024, MTOT, 1024, 1024};
        if (LAYER == 0) { pg8::EpiPLE<false> E{xcur, WSP(bf16_t, WS_XBB), WSP(bf16_t, WS_PPJ), ss_ple, WSP(float, WS_SSB), nullptr}; pg8::gemm_phase(lds, g, S, E); }
        else { pg8::EpiPLE<true> E{xcur, nullptr, WSP(bf16_t, WS_PPJ), ss_ple, nullptr, args.out}; pg8::gemm_phase(lds, g, S, E); }
#if defined(PROBE_DUP_PLE1)
        if (LAYER == 1) { pg8::EpiPLE<true> E{xcur, nullptr, WSP(bf16_t, WS_PPJ), ss_ple, nullptr, args.out}; pg8::gemm_phase(lds, g, S, E); }
#endif
    }
    if (LAYER == 0) SEAM(pw + 3);
#undef IN
#undef SEAM
}

__device__ __forceinline__ void prologue_phase(const Args& args, LAS unsigned char* lds) {
    unsigned char* ws = args.ws; unsigned char* ob = (unsigned char*)args.out;
    int tid = threadIdx.x; asm volatile("" : "+v"(tid));
    const int lane = tid & 63, wave = __builtin_amdgcn_readfirstlane(tid >> 6);
    const int G = gridDim.x, bx = blockIdx.x, vcu = (G % 8 == 0) ? (bx % 8) * (G / 8) + bx / 8 : bx;
    const int gw = vcu * 8 + wave, ngw = G * 8;
    const float* x_prompt = args.in[0]; const float* x_sample = args.in[1]; const float* p_prompt = args.in[2]; const float* p_sample = args.in[3];
    const float* norm_mix = args.in[4]; const float* norm_ffn = args.in[5]; const float* norm_ple = args.in[6];
    bf16_t* xbA = (bf16_t*)(ob + OUT_XBA); bf16_t* pb = (bf16_t*)(ob + OUT_PB); float* ssA = WSP(float, WS_SSA);
    LAS float* scr = (LAS float*)(lds + wave * 16384);
    constexpr int I_QA = 16 * 48, I_QB = 16 * 64, I_OA = 16 * 32, I_OB = 18 * 32, I_GU = 16 * 176, I_DN = 44 * 32, I_PG = 16 * 32, I_PP = 4 * 32;
    constexpr int NITEMS = I_QA + I_QB + I_OA + I_OB + 2 * I_GU + 2 * I_DN + 2 * I_PG + 2 * I_PP;
#pragma unroll 1
    for (int it = gw; it < NITEMS; it += ngw) {
        int r = it;
        const float* W0; const float* W1 = nullptr; int K, Nsrc, mode, nsg; bf16_t* WT; const float* gain = nullptr;
        if (r < I_QA) { W0 = args.in[7]; K = 1024; Nsrc = 1536; WT = WSP(bf16_t, W_QKVA); mode = 1; gain = norm_mix; nsg = 48; }
        else if ((r -= I_QA) < I_QB) { W0 = args.in[12]; K = 1024; Nsrc = 1920; WT = WSP(bf16_t, W_QKVB); mode = 1; gain = norm_mix + 1024; nsg = 64; }
        else if ((r -= I_QB) < I_OA) { W0 = args.in[8]; K = 1024; Nsrc = 1024; WT = WSP(bf16_t, W_OA); mode = 0; nsg = 32; }
        else if ((r -= I_OA) < I_OB) { W0 = args.in[13]; K = 1152; Nsrc = 1024; WT = WSP(bf16_t, W_OB); mode = 0; nsg = 32; }
        else if ((r -= I_OB) < 2 * I_GU) { const int l = r / I_GU; r -= l * I_GU; W0 = args.in[16] + (size_t)l * 1024 * FFN; W1 = args.in[17] + (size_t)l * 1024 * FFN; K = 1024; Nsrc = FFN;
            WT = WSP(bf16_t, W_GU) + (size_t)l * 5632 * 1024; mode = 2; gain = norm_ffn + l * 1024; nsg = 176; }
        else if ((r -= 2 * I_GU) < 2 * I_DN) { const int l = r / I_DN; r -= l * I_DN; W0 = args.in[18] + (size_t)l * FFN * 1024; K = FFN; Nsrc = 1024; WT = WSP(bf16_t, W_DN) + (size_t)l * 1024 * FFN; mode = 0; nsg = 32; }
        else if ((r -= 2 * I_DN) < 2 * I_PG) { const int l = r / I_PG; r -= l * I_PG; W0 = args.in[19] + (size_t)l * 1024 * 1024; K = 1024; Nsrc = 1024; WT = WSP(bf16_t, W_PG) + (size_t)l * 1024 * 1024; mode = 0; gain = norm_ple + l * 1024; nsg = 32; }
        else { r -= 2 * I_PG; const int l = r / I_PP; r -= l * I_PP; W0 = args.in[20] + (size_t)l * 256 * 1024; K = 256; Nsrc = 1024; WT = WSP(bf16_t, W_PP) + (size_t)l * 1024 * 256; mode = 0; nsg = 32; }
        p0_item(W0, W1, K, Nsrc, WT, mode, gain, scr, r, nsg, lane);
    }
#pragma unroll 1
    for (int m0 = gw * 4; m0 < MTOT; m0 += ngw * 4) {
        f32x4 v[4][4];
#pragma unroll
        for (int r = 0; r < 4; ++r) { const int m = m0 + r; const float* xr = m < MPROMPT ? x_prompt + (size_t)m * DM : x_sample + (size_t)(m - MPROMPT) * DM; const f32x4* xv = (const f32x4*)xr + lane;
#pragma unroll
            for (int j = 0; j < 4; ++j) v[r][j] = __builtin_nontemporal_load(xv + 64 * j); }
#pragma unroll
        for (int r = 0; r < 4; ++r) { const int m = m0 + r; float s = 0.f;
#pragma unroll
            for (int j = 0; j < 4; ++j) s += (v[r][j].x * v[r][j].x + v[r][j].y * v[r][j].y) + (v[r][j].z * v[r][j].z + v[r][j].w * v[r][j].w);
            s = wave_sum(s);
            u32x2* o8 = (u32x2*)(xbA + (size_t)m * DM) + lane;
#pragma unroll
            for (int j = 0; j < 4; ++j) { u32x2 w; w.x = cvt_pk_bf16(v[r][j].x, v[r][j].y); w.y = cvt_pk_bf16(v[r][j].z, v[r][j].w); o8[64 * j] = w; }
            if (lane < 16) ssA[(size_t)m * 16 + lane] = lane == 0 ? s : 0.f; }
    }
#pragma unroll 1
    for (int r0 = gw * 8; r0 < 2 * MTOT; r0 += ngw * 8) {
        f32x4 v[8];
#pragma unroll
        for (int r = 0; r < 8; ++r) { const int rr = r0 + r; const int l = rr >= MTOT ? 1 : 0, m = rr - l * MTOT;
            const float* pr = m < MPROMPT ? p_prompt + ((size_t)l * MPROMPT + m) * PLE : p_sample + ((size_t)l * (MTOT - MPROMPT) + (m - MPROMPT)) * PLE;
            v[r] = __builtin_nontemporal_load((const f32x4*)pr + lane); }
#pragma unroll
        for (int r = 0; r < 8; ++r) { u32x2 w; w.x = cvt_pk_bf16(v[r].x, v[r].y); w.y = cvt_pk_bf16(v[r].z, v[r].w); ((u32x2*)(pb + (size_t)(r0 + r) * PLE))[lane] = w; }
    }
    __syncthreads();
}

__global__ void __launch_bounds__(512, 2) fwd_kernel(Args args) {
    extern __shared__ __attribute__((aligned(16))) unsigned char lds_raw[];
    LAS unsigned char* lds = (LAS unsigned char*)lds_raw;
    cg::grid_group grid = cg::this_grid();
    const int lo = args.ph_lo, hi = args.ph_hi;
    volatile LAS unsigned* bst = (volatile LAS unsigned*)(lds + (LDS_BYTES - 64));
    if (threadIdx.x < 2) bst[threadIdx.x] = 0u;
    __syncthreads();
    const XcdBarrier xbar = xcd_barrier_post((unsigned*)(args.ws + WS_BAR), bst);
    if (lo <= 0 && 0 < hi) prologue_phase(args, lds);
    if (lo <= 0 && 1 < hi) grid.sync();
    run_layer<0>(args, lds, xbar, lo, hi);
    run_layer<1>(args, lds, xbar, lo, hi);
}

extern "C" void kernel_launch(void* const* d_in, const int* in_sizes, int n_in, void* d_out, int out_size, void* d_ws, size_t ws_size, hipStream_t stream) {
    static int grid = 0;
    if (grid == 0) {
        if (n_in != 21 || out_size != MTOT * DM || ws_size < WS_END) { fprintf(stderr, "kernel_launch: unexpected sizes (n_in %d out %d ws %zu, need %zu)\n", n_in, out_size, ws_size, (size_t)WS_END); grid = -1; return; }
        int dev = 0, cus = 0, per_cu = 0;
        (void)hipGetDevice(&dev); (void)hipDeviceGetAttribute(&cus, hipDeviceAttributeMultiprocessorCount, dev);
        if (hipFuncSetAttribute((const void*)fwd_kernel, hipFuncAttributeMaxDynamicSharedMemorySize, LDS_BYTES) != hipSuccess) { fprintf(stderr, "kernel_launch: hipFuncSetAttribute failed\n"); grid = -1; return; }
        (void)hipOccupancyMaxActiveBlocksPerMultiprocessor(&per_cu, (const void*)fwd_kernel, 512, LDS_BYTES);
        (void)hipGetLastError();
        if (per_cu < 1) per_cu = 1;
        grid = cus;
    }
    if (grid < 0) return;
    Args a{};
    for (int i = 0; i < 21; ++i) a.in[i] = (const float*)d_in[i];
    a.out = (float*)d_out; a.ws = (unsigned char*)d_ws;
#if MK_SINGLE
    if (hipMemsetAsync((char*)d_ws + WS_BAR, 0, WS_BAR_BYTES, stream) != hipSuccess) { fprintf(stderr, "kernel_launch: hipMemsetAsync failed\n"); return; }
    a.ph_lo = 0; a.ph_hi = NPHASE;
    void* kargs[] = {&a};
    hipError_t e = hipLaunchCooperativeKernel((const void*)fwd_kernel, dim3(grid), dim3(512), kargs, LDS_BYTES, stream);
    if (e != hipSuccess) fprintf(stderr, "cooperative launch failed: %s (grid %d)\n", hipGetErrorString(e), grid);
#else
    for (int k = 0; k < NPHASE; ++k) {
        a.ph_lo = k; a.ph_hi = k + 1;
        hipLaunchKernelGGL(fwd_kernel, dim3(grid), dim3(512), LDS_BYTES, stream, a);
    }
#endif
}
```

```cpp
#include <hip/hip_runtime.h>
#include <hip/hip_cooperative_groups.h>
#include <cstdio>
#include <cstdint>
#include <cmath>
namespace cg = cooperative_groups;

#ifndef MK_SINGLE
#define MK_SINGLE 1
#endif

#define LAS __attribute__((address_space(3)))
typedef unsigned short bf16_t;
typedef short bf16x8 __attribute__((ext_vector_type(8)));
typedef float f32x4 __attribute__((ext_vector_type(4)));
typedef float f32x16 __attribute__((ext_vector_type(16)));
typedef unsigned u32x4 __attribute__((ext_vector_type(4)));
typedef unsigned u32x2 __attribute__((ext_vector_type(2)));

constexpr int DM = 1024, MTOT = 98304, MPROMPT = 65536, LP = 8192, LS = 2048;
constexpr int FFN = 2816, PLE = 256;
constexpr int VTP = MTOT + 128;
constexpr int A_NQ = 16, A_NKV = 4, B_NQ = 18, B_NKV = 6;
constexpr float EPS = 1e-6f, LOG2E = 1.4426950408889634f;

typedef float f32x2_t __attribute__((ext_vector_type(2))); typedef __bf16 bf16x2_t __attribute__((ext_vector_type(2)));
__device__ __forceinline__ unsigned cvt_pk_bf16(float lo, float hi) { f32x2_t v = {lo, hi}; bf16x2_t b = __builtin_convertvector(v, bf16x2_t); return __builtin_bit_cast(unsigned, b); }
__device__ __forceinline__ float bflo(unsigned w) { return __uint_as_float(w << 16); }
__device__ __forceinline__ float bfhi(unsigned w) { return __uint_as_float(w & 0xffff0000u); }
__device__ __forceinline__ float wave_sum(float v) {
#pragma unroll
    for (int o = 1; o < 64; o <<= 1) v += __shfl_xor(v, o);
    return v;
}
__device__ __forceinline__ float row_rstd(const float* ss, int row) {
    const f32x4* p = (const f32x4*)(ss + (size_t)row * 16);
    const f32x4 a = p[0], b = p[1], c = p[2], d = p[3];
    const float s = (((a.x + a.y) + (a.z + a.w)) + ((b.x + b.y) + (b.z + b.w))) + (((c.x + c.y) + (c.z + c.w)) + ((d.x + d.y) + (d.z + d.w)));
    return rsqrtf(s * (1.0f / 1024.0f) + EPS);
}

__device__ __forceinline__ void rows_rstd8(const float* ss, int row0, int lane, float (&rs)[8]) {
    const int fq = lane >> 4, fr = lane & 15;
    float mine[2];
#pragma unroll
    for (int j = 0; j < 2; ++j) { const int k = 2 * fq + j; mine[j] = row_rstd(ss, row0 + 128 * (k >> 2) + 16 * (k & 3)); }
#pragma unroll
    for (int k = 0; k < 8; ++k) rs[k] = __shfl(mine[k & 1], fr + 16 * (k >> 1));
}

namespace pg8 {
constexpr int BM = 256, BK = 64, HALF = 128, HTB = HALF * BK * 2, STAGE_BYTES = 8 * HTB, NXCD = 8, WGM = 8;
__host__ __device__ __forceinline__ int lds_byte(int r, int c) { const int st = (r >> 4) * 2 + (c >> 5), rr = r & 15, cc = c & 31, ob = rr * 64 + cc * 2; return st * 1024 + (ob ^ (((ob >> 9) & 1) << 5)); }
__host__ __device__ __forceinline__ void stage_rc(int b, int& R, int& C) { const int st = b / 1024, sb = b % 1024, swz = sb ^ (((sb >> 9) & 1) << 5); R = (st >> 1) * 16 + swz / 64; C = (st & 1) * 32 + (swz % 64) / 2; }
__host__ __device__ __forceinline__ int perm32(int rho) { const int n = rho >> 4, i = rho & 15; return 8 * (i >> 2) + 4 * n + (i & 3); }

struct Unit { int pm, pn; };
struct Gemm { const bf16_t* A; const bf16_t* Bt; int M, N, K; };

struct StaticOrder {
    int nM, nN, nwg, G, c, rev;
    __host__ __device__ void init(int M, int N, int G_, int c_, int rev_ = 0) { nM = M / BM; nN = N / BM; nwg = nM * nN; G = G_; c = c_; rev = rev_; }
    __host__ __device__ bool next(int i, Unit& u) const {
        const long L = (long)i * G + c; if (L >= nwg) return false;
        int wgid = (int)L; { const int q = nwg / NXCD, r = nwg % NXCD, xcd = wgid % NXCD, off = wgid / NXCD; wgid = (xcd < r ? xcd * (q + 1) : r * (q + 1) + (xcd - r) * q) + off; }
        const int nig = WGM * nN, gid = wgid / nig, fm = gid * WGM, gsz = (nM - fm) < WGM ? (nM - fm) : WGM;
        u.pm = fm + ((wgid % nig) % gsz); u.pn = (wgid % nig) / gsz; if (rev) u.pm = nM - 1 - u.pm; return true;
    }
};

template <class Epi, class Sched, bool ALIGN_EPI = true>
__device__ __forceinline__ void gemm_phase(LAS unsigned char* lds, const Gemm g, const Sched& S, const Epi& E) {
    int tid_ = threadIdx.x; asm volatile("" : "+v"(tid_));
    const int tid = tid_, wid = __builtin_amdgcn_readfirstlane(tid >> 6), lane = tid & 63, wr = wid >> 2, wc = wid & 3, fr = lane & 15, fq = lane >> 4;
    int K_ = g.K; asm volatile("" : "+s"(K_));
    const int K = K_, nt = K / BK;
    unsigned voffA[2], voffB[2];
#pragma unroll
    for (int i = 0; i < 2; ++i) { int R, C; stage_rc(tid * 16 + i * 8192, R, C); const int Rb = (R & ~31) + perm32(R & 31);
        voffA[i] = (unsigned)(R * K + C) * 2u; voffB[i] = (unsigned)(Rb * K + C) * 2u; }
    const size_t kstep = (size_t)(BK * 2);
    const size_t hstep = (size_t)HALF * K * 2;
    const size_t tstep = 2 * hstep;
    const unsigned ldsw = (unsigned)wid * 1024u;
    const int aoff = lds_byte(wr * 64 + fr, fq * 8), boff = lds_byte(wc * 32 + fr, fq * 8);
#define PG8_SA(b, h) (((b) * 2 + (h)) * HTB)
#define PG8_SB(b, h) ((4 + (b) * 2 + (h)) * HTB)
#define PG8_STAGE(bufoff, gbase, voff) do { _Pragma("unroll") for (int _i = 0; _i < 2; ++_i) \
        __builtin_amdgcn_global_load_lds((const unsigned*)((const char*)(gbase) + (voff)[_i]), (LAS unsigned*)(lds + (bufoff) + ldsw + _i * 8192), 16, 0, 0); } while (0)
#define PG8_LDA(dst, b, h) do { _Pragma("unroll") for (int m = 0; m < 4; ++m) _Pragma("unroll") for (int k = 0; k < 2; ++k) dst[m][k] = *(const LAS bf16x8*)(lds + PG8_SA(b, h) + aoff + m * 2048 + k * 1024); } while (0)
#define PG8_LDB(dst, b, h) do { _Pragma("unroll") for (int n = 0; n < 2; ++n) _Pragma("unroll") for (int k = 0; k < 2; ++k) dst[n][k] = *(const LAS bf16x8*)(lds + PG8_SB(b, h) + boff + n * 2048 + k * 1024); } while (0)
#define PG8_MMA(ai, bj, At, Bt) do { __builtin_amdgcn_s_setprio(1); _Pragma("unroll") for (int m = 0; m < 4; ++m) _Pragma("unroll") for (int n = 0; n < 2; ++n) _Pragma("unroll") for (int k = 0; k < 2; ++k) \
        acc[ai][bj][m][n] = __builtin_amdgcn_mfma_f32_16x16x32_bf16(Bt[n][k], At[m][k], acc[ai][bj][m][n], 0, 0, 0); __builtin_amdgcn_s_setprio(0); } while (0)
#define PG8_WAIT_V(n) asm volatile("s_waitcnt vmcnt(" #n ")" ::: "memory")
#define PG8_WAIT_L(n) asm volatile("s_waitcnt lgkmcnt(" #n ")" ::: "memory")
#define PG8_BAR __builtin_amdgcn_s_barrier()
#define PG8_SCHED __builtin_amdgcn_sched_barrier(0)
    Unit cur, nxt; int ui = 0;
    if (!S.next(0, cur)) return;
    f32x4 acc[2][2][4][2];
#pragma unroll
    for (int a = 0; a < 2; ++a)
#pragma unroll
        for (int b = 0; b < 2; ++b)
#pragma unroll
            for (int m = 0; m < 4; ++m)
#pragma unroll
                for (int n = 0; n < 2; ++n) acc[a][b][m][n] = (f32x4){0.f, 0.f, 0.f, 0.f};
    bf16x8 At[4][2], B0[2][2], B1[2][2];
    const char* cA = (const char*)g.A + (size_t)cur.pm * tstep; const char* cB = (const char*)g.Bt + (size_t)cur.pn * tstep;
    PG8_STAGE(PG8_SB(0, 0), cB, voffB); PG8_STAGE(PG8_SB(0, 1), cB + hstep, voffB); PG8_STAGE(PG8_SA(0, 0), cA, voffA); PG8_STAGE(PG8_SA(0, 1), cA + hstep, voffA);
    if (wr == 1) PG8_BAR;
    PG8_WAIT_V(2); PG8_BAR;
    PG8_STAGE(PG8_SB(1, 0), cB + kstep, voffB); PG8_STAGE(PG8_SA(1, 0), cA + kstep, voffA); PG8_STAGE(PG8_SB(1, 1), cB + hstep + kstep, voffB);
    PG8_WAIT_V(6); PG8_BAR;
    for (;;) {
        const bool has_next = S.next(ui + 1, nxt);
        const char* nA = has_next ? (const char*)g.A + (size_t)nxt.pm * tstep : cA; const char* nB = has_next ? (const char*)g.Bt + (size_t)nxt.pn * tstep : cB;
        for (int t = 0; t < nt; t += 2) {
            const bool last = (t == nt - 2);
            const char* a1 = cA + (size_t)(t + 1) * kstep;
            const char* a2 = last ? nA : cA + (size_t)(t + 2) * kstep; const char* b2 = last ? nB : cB + (size_t)(t + 2) * kstep;
            const char* a3 = a2 + kstep; const char* b3 = b2 + kstep;
            PG8_LDB(B0, 0, 0); PG8_LDB(B1, 0, 1); PG8_SCHED; PG8_LDA(At, 0, 0); PG8_STAGE(PG8_SA(1, 1), a1 + hstep, voffA);
            PG8_WAIT_V(8); PG8_WAIT_L(0); PG8_BAR; PG8_MMA(0, 0, At, B0); PG8_MMA(0, 1, At, B1); PG8_BAR; PG8_SCHED;
            PG8_LDA(At, 0, 1); PG8_STAGE(PG8_SB(0, 0), b2, voffB); PG8_STAGE(PG8_SB(0, 1), b2 + hstep, voffB); PG8_STAGE(PG8_SA(0, 0), a2, voffA);
            PG8_WAIT_V(8); PG8_WAIT_L(0); PG8_BAR; PG8_MMA(1, 0, At, B0); PG8_MMA(1, 1, At, B1); PG8_BAR; PG8_SCHED;
            PG8_LDB(B0, 1, 0); PG8_LDB(B1, 1, 1); PG8_SCHED; PG8_LDA(At, 1, 0); PG8_STAGE(PG8_SA(0, 1), a2 + hstep, voffA);
            PG8_WAIT_V(8); PG8_WAIT_L(0); PG8_BAR; PG8_MMA(0, 0, At, B0); PG8_MMA(0, 1, At, B1); PG8_BAR; PG8_SCHED;
            PG8_LDA(At, 1, 1); PG8_STAGE(PG8_SB(1, 0), b3, voffB); PG8_STAGE(PG8_SB(1, 1), b3 + hstep, voffB); PG8_STAGE(PG8_SA(1, 0), a3, voffA);
            PG8_WAIT_V(8); PG8_WAIT_L(0); PG8_BAR; PG8_MMA(1, 0, At, B0); PG8_MMA(1, 1, At, B1); PG8_BAR; PG8_SCHED;
        }
        if constexpr (ALIGN_EPI) { if (wr == 0) PG8_BAR; }
        E(acc, cur, wr, wc, fr, fq);
        if (!has_next) break;
#pragma unroll
        for (int a = 0; a < 2; ++a)
#pragma unroll
            for (int b = 0; b < 2; ++b)
#pragma unroll
                for (int m = 0; m < 4; ++m)
#pragma unroll
                    for (int n = 0; n < 2; ++n) acc[a][b][m][n] = (f32x4){0.f, 0.f, 0.f, 0.f};
        cur = nxt; cA = nA; cB = nB; ++ui;
        if constexpr (ALIGN_EPI) { if (wr == 1) PG8_BAR; }
    }
    PG8_WAIT_V(0);
    if constexpr (!ALIGN_EPI) { if (wr == 0) PG8_BAR; }
    PG8_BAR;
#undef PG8_SA
#undef PG8_SB
#undef PG8_STAGE
#undef PG8_LDA
#undef PG8_LDB
#undef PG8_MMA
#undef PG8_WAIT_V
#undef PG8_WAIT_L
#undef PG8_BAR
#undef PG8_SCHED
}

struct EpiPlain {
    bf16_t* O; int ldc;
    __device__ __forceinline__ void operator()(const f32x4 (&acc)[2][2][4][2], const Unit& u, int wr, int wc, int fr, int fq) const {
        const int row0 = u.pm * BM + wr * 64 + fr, col0 = u.pn * BM + wc * 32 + 8 * fq;
#pragma unroll
        for (int ai = 0; ai < 2; ++ai)
#pragma unroll
            for (int m = 0; m < 4; ++m) { bf16_t* rowp = O + (size_t)(row0 + ai * HALF + m * 16) * ldc + col0;
#pragma unroll
                for (int bj = 0; bj < 2; ++bj) { const f32x4 v0 = acc[ai][bj][m][0], v1 = acc[ai][bj][m][1];
                    u32x4 w; w.x = cvt_pk_bf16(v0[0], v0[1]); w.y = cvt_pk_bf16(v0[2], v0[3]); w.z = cvt_pk_bf16(v1[0], v1[1]); w.w = cvt_pk_bf16(v1[2], v1[3]);
                    *(u32x4*)(rowp + bj * HALF) = w; } }
    }
};

template <bool LB> struct EpiQKV {
    bf16_t* Q; bf16_t* Kb; bf16_t* VT; const float* ss; const float* qgain; const float* kgain;
    __device__ __forceinline__ void operator()(const f32x4 (&acc)[2][2][4][2], const Unit& u, int wr, int wc, int fr, int fq) const {
        constexpr int NQ = LB ? B_NQ : A_NQ, NKV = LB ? B_NKV : A_NKV, LDQ = NQ * 64, LDK = NKV * 64;
        const int head = u.pn * 4 + wc;
        if (head >= NQ + 2 * NKV) return;
        const int kind = head < NQ ? 0 : (head < NQ + NKV ? 1 : 2);
        const int row0 = u.pm * BM + wr * 64 + fr;
        if (kind < 2) {
            const float* gp = (kind == 0 ? qgain : kgain) + 8 * fq;
            f32x4 gv[2][2];
#pragma unroll
            for (int bj = 0; bj < 2; ++bj)
#pragma unroll
                for (int n = 0; n < 2; ++n) gv[bj][n] = *(const f32x4*)(gp + 32 * bj + 4 * n);
            const float post = kind == 0 ? 0.125f * LOG2E : 1.0f;
            bf16_t* base = kind == 0 ? (Q + head * 64 + 8 * fq) : (Kb + (head - NQ) * 64 + 8 * fq);
            const int ld = kind == 0 ? LDQ : LDK;
            float rs8[8]; rows_rstd8(ss, row0, fq * 16 + fr, rs8);
#pragma unroll
            for (int ai = 0; ai < 2; ++ai)
#pragma unroll
                for (int m = 0; m < 4; ++m) {
                    const int row = row0 + ai * HALF + m * 16;
                    float s2 = 0.f;
#pragma unroll
                    for (int bj = 0; bj < 2; ++bj)
#pragma unroll
                        for (int n = 0; n < 2; ++n) { const f32x4 a = acc[ai][bj][m][n]; s2 += (a[0] * a[0] + a[1] * a[1]) + (a[2] * a[2] + a[3] * a[3]); }
                    s2 += __shfl_xor(s2, 16); s2 += __shfl_xor(s2, 32);
                    const float rs = rs8[ai * 4 + m];
                    const float sc = rs * rsqrtf(rs * rs * s2 * (1.0f / 64.0f) + EPS) * post;
                    bf16_t* rowp = base + (size_t)row * ld;
#pragma unroll
                    for (int bj = 0; bj < 2; ++bj) { const f32x4 v0 = acc[ai][bj][m][0] * sc * gv[bj][0], v1 = acc[ai][bj][m][1] * sc * gv[bj][1];
                        u32x4 w; w.x = cvt_pk_bf16(v0[0], v0[1]); w.y = cvt_pk_bf16(v0[2], v0[3]); w.z = cvt_pk_bf16(v1[0], v1[1]); w.w = cvt_pk_bf16(v1[2], v1[3]);
                        *(u32x4*)(rowp + 32 * bj) = w; }
                }
        } else {
            bf16_t* base = VT + (head - NQ - NKV) * 64 + 8 * fq;
            float rs8[8]; rows_rstd8(ss, row0, fq * 16 + fr, rs8);
#pragma unroll
            for (int ai = 0; ai < 2; ++ai)
#pragma unroll
                for (int m = 0; m < 4; ++m) {
                    const int row = row0 + ai * HALF + m * 16;
                    const float rs = rs8[ai * 4 + m];
                    bf16_t* rowp = base + (size_t)row * LDK;
#pragma unroll
                    for (int bj = 0; bj < 2; ++bj) { const f32x4 v0 = acc[ai][bj][m][0] * rs, v1 = acc[ai][bj][m][1] * rs;
                        u32x4 w; w.x = cvt_pk_bf16(v0[0], v0[1]); w.y = cvt_pk_bf16(v0[2], v0[3]); w.z = cvt_pk_bf16(v1[0], v1[1]); w.w = cvt_pk_bf16(v1[2], v1[3]);
                        *(u32x4*)(rowp + 32 * bj) = w; }
                }
        }
    }
};

struct EpiResid {
    bf16_t* X; float* ss_out;
    __device__ __forceinline__ void operator()(const f32x4 (&acc)[2][2][4][2], const Unit& u, int wr, int wc, int fr, int fq) const {
        const int row0 = u.pm * BM + wr * 64 + fr, col0 = u.pn * BM + wc * 32 + 8 * fq;
        bf16_t* base = X + (size_t)row0 * DM + col0;
        u32x4 xw[2][4][2];
#pragma unroll
        for (int ai = 0; ai < 2; ++ai)
#pragma unroll
            for (int m = 0; m < 4; ++m)
#pragma unroll
                for (int bj = 0; bj < 2; ++bj) xw[ai][m][bj] = *(const u32x4*)(base + (size_t)(ai * HALF + m * 16) * DM + bj * HALF);
#pragma unroll
        for (int ai = 0; ai < 2; ++ai)
#pragma unroll
            for (int m = 0; m < 4; ++m) { const int row = row0 + ai * HALF + m * 16; bf16_t* rowp = base + (size_t)(ai * HALF + m * 16) * DM; float s = 0.f;
#pragma unroll
                for (int bj = 0; bj < 2; ++bj) { const u32x4 w_ = xw[ai][m][bj]; f32x4 v0 = acc[ai][bj][m][0], v1 = acc[ai][bj][m][1];
                    v0[0] += bflo(w_.x); v0[1] += bfhi(w_.x); v0[2] += bflo(w_.y); v0[3] += bfhi(w_.y); v1[0] += bflo(w_.z); v1[1] += bfhi(w_.z); v1[2] += bflo(w_.w); v1[3] += bfhi(w_.w);
                    s += ((v0[0] * v0[0] + v0[1] * v0[1]) + (v0[2] * v0[2] + v0[3] * v0[3])) + ((v1[0] * v1[0] + v1[1] * v1[1]) + (v1[2] * v1[2] + v1[3] * v1[3]));
                    u32x4 w; w.x = cvt_pk_bf16(v0[0], v0[1]); w.y = cvt_pk_bf16(v0[2], v0[3]); w.z = cvt_pk_bf16(v1[0], v1[1]); w.w = cvt_pk_bf16(v1[2], v1[3]);
                    *(u32x4*)(rowp + bj * HALF) = w; }
                s += __shfl_xor(s, 16); s += __shfl_xor(s, 32);
                if (fq == 0) ss_out[(size_t)row * 16 + u.pn * 4 + wc] = s; }
    }
};

struct EpiGU {
    bf16_t* H; const float* ss;
    __device__ __forceinline__ void operator()(const f32x4 (&acc)[2][2][4][2], const Unit& u, int wr, int wc, int fr, int fq) const {
        const int row0 = u.pm * BM + wr * 64 + fr, col0 = u.pn * HALF + wc * 32 + 8 * fq;
        float rs8[8]; rows_rstd8(ss, row0, fq * 16 + fr, rs8);
#pragma unroll
        for (int ai = 0; ai < 2; ++ai)
#pragma unroll
            for (int m = 0; m < 4; ++m) { const int row = row0 + ai * HALF + m * 16; const float rs = rs8[ai * 4 + m];
                float h[8];
#pragma unroll
                for (int n = 0; n < 2; ++n)
#pragma unroll
                    for (int i = 0; i < 4; ++i) { const float gg = acc[ai][0][m][n][i] * rs, uu = acc[ai][1][m][n][i] * rs;
                        h[4 * n + i] = gg * uu * __builtin_amdgcn_rcpf(1.0f + __builtin_amdgcn_exp2f(-gg * LOG2E)); }
                u32x4 w; w.x = cvt_pk_bf16(h[0], h[1]); w.y = cvt_pk_bf16(h[2], h[3]); w.z = cvt_pk_bf16(h[4], h[5]); w.w = cvt_pk_bf16(h[6], h[7]);
                *(u32x4*)(H + (size_t)row * FFN + col0) = w; }
    }
};

template <bool LAST> struct EpiPLE {
    const bf16_t* Xin; bf16_t* Xout; const bf16_t* PP; const float* ss; float* ss_out; float* out;
    __device__ __forceinline__ void operator()(const f32x4 (&acc)[2][2][4][2], const Unit& u, int wr, int wc, int fr, int fq) const {
        const int row0 = u.pm * BM + wr * 64 + fr, col0 = u.pn * BM + wc * 32 + 8 * fq;
        float rs8[8]; rows_rstd8(ss, row0, fq * 16 + fr, rs8);
#pragma unroll
        for (int ai = 0; ai < 2; ++ai) {
            u32x4 xw[4][2], pw[4][2];
#pragma unroll
            for (int m = 0; m < 4; ++m)
#pragma unroll
                for (int bj = 0; bj < 2; ++bj) { const size_t off = (size_t)(row0 + ai * HALF + m * 16) * DM + col0 + bj * HALF; xw[m][bj] = *(const u32x4*)(Xin + off); pw[m][bj] = *(const u32x4*)(PP + off); }
            asm volatile("" ::: "memory");
#pragma unroll
            for (int m = 0; m < 4; ++m) { const int row = row0 + ai * HALF + m * 16; const float rs = rs8[ai * 4 + m]; const size_t off = (size_t)row * DM + col0; float s = 0.f;
#pragma unroll
                for (int bj = 0; bj < 2; ++bj) { const u32x4 xq_ = xw[m][bj], pq_ = pw[m][bj];
                    float xv[8] = {bflo(xq_.x), bfhi(xq_.x), bflo(xq_.y), bfhi(xq_.y), bflo(xq_.z), bfhi(xq_.z), bflo(xq_.w), bfhi(xq_.w)};
                    const float pv[8] = {bflo(pq_.x), bfhi(pq_.x), bflo(pq_.y), bfhi(pq_.y), bflo(pq_.z), bfhi(pq_.z), bflo(pq_.w), bfhi(pq_.w)};
#pragma unroll
                    for (int n = 0; n < 2; ++n)
#pragma unroll
                        for (int i = 0; i < 4; ++i) { const float a = acc[ai][bj][m][n][i] * rs; const float gate = __builtin_amdgcn_rcpf(1.0f + __builtin_amdgcn_exp2f(-a * LOG2E));
                            xv[4 * n + i] += gate * pv[4 * n + i]; s += xv[4 * n + i] * xv[4 * n + i]; }
                    if (LAST) { *(f32x4*)(out + off + bj * HALF) = (f32x4){xv[0], xv[1], xv[2], xv[3]}; *(f32x4*)(out + off + bj * HALF + 4) = (f32x4){xv[4], xv[5], xv[6], xv[7]}; }
                    else { u32x4 w; w.x = cvt_pk_bf16(xv[0], xv[1]); w.y = cvt_pk_bf16(xv[2], xv[3]); w.z = cvt_pk_bf16(xv[4], xv[5]); w.w = cvt_pk_bf16(xv[6], xv[7]); *(u32x4*)(Xout + off + bj * HALF) = w; } }
                if (!LAST) { s += __shfl_xor(s, 16); s += __shfl_xor(s, 32); if (fq == 0) ss_out[(size_t)row * 16 + u.pn * 4 + wc] = s; } }
        }
    }
};
}

struct AttnP { const bf16_t* Q; bf16_t* O; const bf16_t* Kb; const bf16_t* Vb; float* LSE; const float* sink; const float* qg; const float* kg; };
__device__ __forceinline__ float xhalf_max(float m) { auto rr = __builtin_amdgcn_permlane32_swap(__float_as_uint(m), __float_as_uint(m), false, false); return fmaxf(__uint_as_float(rr[0]), __uint_as_float(rr[1])); }
__device__ __forceinline__ float xhalf_sum(float m) { auto rr = __builtin_amdgcn_permlane32_swap(__float_as_uint(m), __float_as_uint(m), false, false); return __uint_as_float(rr[0]) + __uint_as_float(rr[1]); }

template <bool LB>
__device__ __forceinline__ void attn_phase(const AttnP P, LAS unsigned char* lds, int vcu, int G, int wave, int lane) {
    constexpr int R = LB ? 64 : 128, NT = 2 * R / 32 + 1, TD = R / 32, HPT = LB ? 1 : 2, WPS = LB ? 4 : 8, NR = LB ? 3 : 1;
    constexpr int W = 128 + 2 * R, KP = 144, VPB = (W + 8) * 2, SUBB = W * KP + 64 * VPB;
    constexpr int NBT = LB ? 2304 : 3072;
    constexpr int LDQ = (LB ? B_NQ : A_NQ) * 64, LDK = (LB ? B_NKV : A_NKV) * 64;
    static_assert((8 / WPS) * SUBB <= 147456, "attention LDS");
    const int NI = (NBT + G - 1) / G;
    const int q = lane & 31, hi = lane >> 5;
    const int sub = wave / WPS, wsub = wave % WPS;
    const float xq = (float)(4 * hi - q);
    float bnd; { float gq = fabsf(P.qg[lane]), gk = fabsf(P.kg[lane]);
#pragma unroll
        for (int o = 1; o < 64; o <<= 1) { gq = fmaxf(gq, __shfl_xor(gq, o)); gk = fmaxf(gk, __shfl_xor(gk, o)); }
        bnd = 8.0f * LOG2E * 1.02f * gq * gk; }
    const int vro0 = q * VPB, vro1 = (32 + q) * VPB, dsw0 = q & ~7, dsw1 = 32 + (q & ~7);
#pragma unroll 1
    for (int it = 0; it < NI; ++it) {
        const int bt = it * G + vcu; if (bt >= NBT) break;
        const int st = LB ? bt * 2 + sub : bt;
        int hq0, kvh, ld, blk;
        if (LB) { const int kvc = st & 1, tb = st >> 1, g = tb / 768; blk = tb - g * 768; kvh = 2 * g + kvc; hq0 = 6 * g; ld = 2 * g; }
        else { kvh = st & 3; blk = st >> 2; hq0 = kvh * 4; ld = 0; }
        int sb, lsh, w;
        if (blk < 512) { lsh = 13; sb = (blk >> 6) << 13; w = blk & 63; } else { const int bb = blk - 512; lsh = 11; sb = MPROMPT + ((bb >> 4) << 11); w = bb & 15; }
        const int lrs = lsh - ld;
        const int Lr = 1 << lrs, res = w >> (lrs - 7), i0b = (w & ((1 << (lrs - 7)) - 1)) << 7;
        {
            LAS unsigned char* Ks = lds + sub * SUBB; LAS unsigned char* Vs = Ks + W * KP;
            const int ws0 = i0b - R, c = lane & 7;
            const bf16_t* kg = P.Kb + ((size_t)sb + res) * LDK + kvh * 64 + 8 * c;
            const bf16_t* vg = P.Vb + ((size_t)sb + res) * LDK + kvh * 64 + 8 * c;
            constexpr int NSTG = W / (8 * WPS);
            u32x4 kv[NSTG], vv[NSTG];
#pragma unroll
            for (int k = 0; k < NSTG; ++k) {
                const int p = 8 * (k * WPS + wsub) + (lane >> 3); int kj = ws0 + p; kj = kj < 0 ? 0 : kj; kj = kj >= Lr ? Lr - 1 : kj;
                const size_t ro = ((size_t)kj << ld) * LDK;
                kv[k] = *(const u32x4*)(kg + ro); vv[k] = *(const u32x4*)(vg + ro);
            }
#pragma unroll
            for (int k = 0; k < NSTG; ++k) {
                const int p = 8 * (k * WPS + wsub) + (lane >> 3);
                *(LAS u32x4*)(Ks + p * KP + c * 16) = kv[k];
                const int pp = (p & ~12) | ((p & 4) << 1) | ((p & 8) >> 1);
                LAS unsigned short* vp = (LAS unsigned short*)(Vs + (8 * c) * VPB + ((pp ^ (c << 3)) * 2));
                vp[0] = (unsigned short)(vv[k].x & 0xffffu); vp[VPB / 2] = (unsigned short)(vv[k].x >> 16); vp[2 * (VPB / 2)] = (unsigned short)(vv[k].y & 0xffffu); vp[3 * (VPB / 2)] = (unsigned short)(vv[k].y >> 16);
                vp[4 * (VPB / 2)] = (unsigned short)(vv[k].z & 0xffffu); vp[5 * (VPB / 2)] = (unsigned short)(vv[k].z >> 16); vp[6 * (VPB / 2)] = (unsigned short)(vv[k].w & 0xffffu); vp[7 * (VPB / 2)] = (unsigned short)(vv[k].w >> 16);
            }
        }
        bf16x8 qfr[NR][HPT][4];
#pragma unroll
        for (int rd = 0; rd < NR; ++rd) {
            int qtile, hqr;
            if (LB) { const int j = rd * 8 + wave; const int cs = j >= 12 ? 1 : 0; const int rem = j - 12 * cs; qtile = rem & 3; hqr = hq0 + 3 * cs + (rem >> 2); }
            else { qtile = wave & 3; hqr = hq0 + 2 * (wave >> 2); }
            const unsigned rowq_ = (unsigned)sb + ((unsigned)(i0b + 32 * qtile + q) << ld) + res;
            const char* Qp_ = (const char*)(P.Q + hqr * 64) + (rowq_ * LDQ + 4 * hi) * 2u + 8 * hi;
#pragma unroll
            for (int h = 0; h < HPT; ++h)
#pragma unroll
                for (int s = 0; s < 4; ++s) qfr[rd][h][s] = *(const bf16x8*)(Qp_ + (h * 64 + 16 * s) * 2);
        }
        __syncthreads();
#pragma unroll
        for (int rd = 0; rd < NR; ++rd) {
        int csub, qtile, hqr;
        if (LB) { const int j = rd * 8 + wave; csub = j >= 12 ? 1 : 0; const int rem = j - 12 * csub; qtile = rem & 3; hqr = hq0 + 3 * csub + (rem >> 2); }
        else { csub = 0; qtile = wave & 3; hqr = hq0 + 2 * (wave >> 2); }
        const LAS unsigned char* Ks = lds + csub * SUBB; const LAS unsigned char* Vs = Ks + W * KP;
        const int i0 = i0b + 32 * qtile, kro = (32 * qtile + q) * KP + 16 * hi, pos0 = 32 * qtile + 8 * hi;
        const unsigned rowq = (unsigned)sb + ((unsigned)(i0 + q) << ld) + res;
        const unsigned qoff = (rowq * LDQ + 4 * hi) * 2u;
        bf16x8 qf[HPT][4]; float l[HPT], nslope2[HPT]; f32x16 o0[HPT], o1[HPT];
#pragma unroll
        for (int h = 0; h < HPT; ++h) {
#pragma unroll
            for (int s = 0; s < 4; ++s) qf[h][s] = qfr[rd][h][s];
            if (LB) { l[h] = 0.f; } else { l[h] = hi == 0 ? __builtin_amdgcn_exp2f(P.sink[hqr + h] * LOG2E - bnd) : 0.f; }
            nslope2[h] = -exp2f(-8.0f * (float)(hqr + h + 1) / (float)(LB ? B_NQ : A_NQ)) * (float)(1 << ld) * LOG2E;
#pragma unroll
            for (int r = 0; r < 16; ++r) { o0[h][r] = 0.f; o1[h][r] = 0.f; }
        }
        int t_lo = (R - i0) >> 5; if (t_lo < 0) t_lo = 0;
        int t_hi = (Lr - i0 + R) >> 5; if (t_hi > NT) t_hi = NT;
#pragma unroll 1
        for (int i = 0; i < NT; ++i) {
            const int t = TD + ((i & 1) ? -((i + 1) >> 1) : (i >> 1));
            if (t < t_lo || t >= t_hi) continue;
            bf16x8 kf[4], vf[2][2];
#pragma unroll
            for (int s = 0; s < 4; ++s) kf[s] = *(const LAS bf16x8*)(Ks + kro + t * (32 * KP) + 32 * s);
#pragma unroll
            for (int s = 0; s < 2; ++s) { const int pos = pos0 + 32 * t + 16 * s;
                vf[s][0] = *(const LAS bf16x8*)(Vs + vro0 + ((pos ^ dsw0) * 2)); vf[s][1] = *(const LAS bf16x8*)(Vs + vro1 + ((pos ^ dsw1) * 2)); }
            const bool edge = (t == 0) || (t == NT - 1);
            const float xb_ = xq + (float)(32 * t - R);
#pragma unroll
            for (int h = 0; h < HPT; ++h) {
                f32x16 S;
                if (edge || t == TD) {
#pragma unroll
                    for (int r = 0; r < 16; ++r) { const float x = __builtin_fabsf(xb_ + (float)((r & 3) + 8 * (r >> 2))); float c = fmaf(nslope2[h], x, -bnd); if (edge && x > (float)R) c = -INFINITY; S[r] = c; }
                } else {
                    const float sg = t > TD ? nslope2[h] : -nslope2[h]; const float a0 = fmaf(sg, xb_, -bnd);
#pragma unroll
                    for (int r = 0; r < 16; ++r) S[r] = fmaf(sg, (float)((r & 3) + 8 * (r >> 2)), a0);
                }
#pragma unroll
                for (int s = 0; s < 4; ++s) S = __builtin_amdgcn_mfma_f32_32x32x16_bf16(kf[s], qf[h][s], S, 0, 0, 0);
                float ps = 0.f;
#pragma unroll
                for (int r = 0; r < 16; ++r) { const float p = __builtin_amdgcn_exp2f(S[r]); S[r] = p; ps += p; }
                l[h] += ps;
                u32x4 w0, w1;
                w0.x = cvt_pk_bf16(S[0], S[1]); w0.y = cvt_pk_bf16(S[2], S[3]); w0.z = cvt_pk_bf16(S[4], S[5]); w0.w = cvt_pk_bf16(S[6], S[7]);
                w1.x = cvt_pk_bf16(S[8], S[9]); w1.y = cvt_pk_bf16(S[10], S[11]); w1.z = cvt_pk_bf16(S[12], S[13]); w1.w = cvt_pk_bf16(S[14], S[15]);
                const bf16x8 pf0 = __builtin_bit_cast(bf16x8, w0), pf1 = __builtin_bit_cast(bf16x8, w1);
                o0[h] = __builtin_amdgcn_mfma_f32_32x32x16_bf16(vf[0][0], pf0, o0[h], 0, 0, 0);
                o1[h] = __builtin_amdgcn_mfma_f32_32x32x16_bf16(vf[0][1], pf0, o1[h], 0, 0, 0);
                o0[h] = __builtin_amdgcn_mfma_f32_32x32x16_bf16(vf[1][0], pf1, o0[h], 0, 0, 0);
                o1[h] = __builtin_amdgcn_mfma_f32_32x32x16_bf16(vf[1][1], pf1, o1[h], 0, 0, 0);
            }
        }
#pragma unroll
        for (int h = 0; h < HPT; ++h) {
            const float lt = xhalf_sum(l[h]);
            const float inv = 1.0f / lt;
            char* Op = (char*)(P.O + (hqr + h) * 64) + (qoff - 8u * hi) + 16u * hi;
#pragma unroll
            for (int pr = 0; pr < 2; ++pr) {
                const int a0 = 2 * pr, a1 = 2 * pr + 1;
                const unsigned Ax0 = cvt_pk_bf16(o0[h][4 * a0] * inv, o0[h][4 * a0 + 1] * inv), Ay0 = cvt_pk_bf16(o0[h][4 * a0 + 2] * inv, o0[h][4 * a0 + 3] * inv);
                const unsigned Bx0 = cvt_pk_bf16(o0[h][4 * a1] * inv, o0[h][4 * a1 + 1] * inv), By0 = cvt_pk_bf16(o0[h][4 * a1 + 2] * inv, o0[h][4 * a1 + 3] * inv);
                const unsigned Ax1 = cvt_pk_bf16(o1[h][4 * a0] * inv, o1[h][4 * a0 + 1] * inv), Ay1 = cvt_pk_bf16(o1[h][4 * a0 + 2] * inv, o1[h][4 * a0 + 3] * inv);
                const unsigned Bx1 = cvt_pk_bf16(o1[h][4 * a1] * inv, o1[h][4 * a1 + 1] * inv), By1 = cvt_pk_bf16(o1[h][4 * a1 + 2] * inv, o1[h][4 * a1 + 3] * inv);
                const auto sx0 = __builtin_amdgcn_permlane32_swap(Ax0, Bx0, false, false), sy0 = __builtin_amdgcn_permlane32_swap(Ay0, By0, false, false);
                const auto sx1 = __builtin_amdgcn_permlane32_swap(Ax1, Bx1, false, false), sy1 = __builtin_amdgcn_permlane32_swap(Ay1, By1, false, false);
                u32x4 w0, w1; w0.x = sx0[0]; w0.y = sy0[0]; w0.z = sx0[1]; w0.w = sy0[1]; w1.x = sx1[0]; w1.y = sy1[0]; w1.z = sx1[1]; w1.w = sy1[1];
                *(u32x4*)(Op + 32 * pr) = w0; *(u32x4*)(Op + 64 + 32 * pr) = w1;
            }
            if (LB) { if (hi == 0) *(float*)((char*)(P.LSE + hqr + h) + rowq * (B_NQ * 4)) = bnd + log2f(lt); }
        }
        }
        __syncthreads();
    }
}

__device__ __forceinline__ void combine_phase(bf16_t* O, const float* LSE, int gw, int ngw, int lane) {
    int idx[3], g[3], j[3];
#pragma unroll
    for (int i = 0; i < 3; ++i) { idx[i] = lane + 64 * i; const int head = (idx[i] < 144 ? idx[i] : 0) >> 3; g[i] = head / 6; j[i] = head - 6 * g[i]; }
#pragma unroll 1
    for (int row0 = MTOT - 4 - gw * 4; row0 >= 0; row0 -= ngw * 4) {
        u32x4 w[4][3]; float al[4][3];
#pragma unroll
        for (int r = 0; r < 4; ++r) { const bf16_t* rp = O + (size_t)(row0 + r) * (B_NQ * 64);
#pragma unroll
            for (int i = 0; i < 3; ++i) if (i < 2 || idx[i] < 144) w[r][i] = *(const u32x4*)(rp + 8 * idx[i]); }
#pragma unroll
        for (int r = 0; r < 4; ++r) { const float* lp = LSE + (size_t)(row0 + r) * B_NQ;
#pragma unroll
            for (int i = 0; i < 3; ++i) { const float l0 = lp[j[i]], l1 = lp[6 + j[i]], l2 = lp[12 + j[i]]; const float mx = fmaxf(l0, fmaxf(l1, l2));
                const float e0 = __builtin_amdgcn_exp2f(l0 - mx), e1 = __builtin_amdgcn_exp2f(l1 - mx), e2 = __builtin_amdgcn_exp2f(l2 - mx);
                al[r][i] = (g[i] == 0 ? e0 : (g[i] == 1 ? e1 : e2)) / (e0 + e1 + e2); } }
#pragma unroll
        for (int r = 0; r < 4; ++r) { bf16_t* rp = O + (size_t)(row0 + r) * (B_NQ * 64);
#pragma unroll
            for (int i = 0; i < 3; ++i) if (i < 2 || idx[i] < 144) { u32x4 v = w[r][i]; const float a_ = al[r][i];
                v.x = cvt_pk_bf16(bflo(v.x) * a_, bfhi(v.x) * a_); v.y = cvt_pk_bf16(bflo(v.y) * a_, bfhi(v.y) * a_); v.z = cvt_pk_bf16(bflo(v.z) * a_, bfhi(v.z) * a_); v.w = cvt_pk_bf16(bflo(v.w) * a_, bfhi(v.w) * a_);
                *(u32x4*)(rp + 8 * idx[i]) = v; } }
    }
}

__device__ __forceinline__ void p0_item(const float* W0, const float* W1, int K, int Nsrc, bf16_t* WT, int mode, const float* gain, LAS float* scr, int item, int nsg, int lane) {
    const int kb = item / nsg, sg = item - kb * nsg, k0 = 64 * kb, s0 = 32 * sg;
    const float* W = W0; int c0 = s0; bool valid = true;
    if (mode == 1) { const int pn = s0 >> 8, bj = (s0 >> 7) & 1, wc = (s0 >> 5) & 3; c0 = pn * 256 + wc * 64 + bj * 32; valid = c0 < Nsrc; }
    else if (mode == 2) { const int pn = s0 >> 8, bj = (s0 >> 7) & 1, wc = (s0 >> 5) & 3; c0 = pn * 128 + wc * 32; W = bj ? W1 : W0; }
#pragma unroll 8
    for (int i = 0; i < 32; ++i) { const int kk = 2 * i + (lane >> 5); float v = 0.f;
        if (valid) { v = W[(size_t)(k0 + kk) * Nsrc + c0 + (lane & 31)]; if (gain) v *= gain[k0 + kk]; }
        scr[kk * 33 + (lane & 31)] = v; }
    asm volatile("s_waitcnt lgkmcnt(0)" ::: "memory");
    const int c = lane & 7;
#pragma unroll
    for (int j = 0; j < 4; ++j) { const int n = (lane >> 3) + 8 * j; const LAS float* s = scr + (8 * c) * 33 + n;
        u32x4 o; o.x = cvt_pk_bf16(s[0 * 33], s[1 * 33]); o.y = cvt_pk_bf16(s[2 * 33], s[3 * 33]); o.z = cvt_pk_bf16(s[4 * 33], s[5 * 33]); o.w = cvt_pk_bf16(s[6 * 33], s[7 * 33]);
        *(u32x4*)(WT + (size_t)(s0 + n) * K + k0 + 8 * c) = o; }
    asm volatile("s_waitcnt lgkmcnt(0)" ::: "memory");
}

constexpr size_t MiB = 1u << 20;
constexpr size_t W_QKVA = 0, W_QKVB = W_QKVA + (size_t)1536 * 1024 * 2, W_OA = W_QKVB + (size_t)2048 * 1024 * 2, W_OB = W_OA + (size_t)1024 * 1024 * 2,
                 W_GU = W_OB + (size_t)1024 * 1152 * 2, W_DN = W_GU + (size_t)2 * 5632 * 1024 * 2, W_PG = W_DN + (size_t)2 * 1024 * 2816 * 2, W_PP = W_PG + (size_t)2 * 1024 * 1024 * 2,
                 W_END = W_PP + (size_t)2 * 1024 * 256 * 2;
static_assert(W_END <= 56 * MiB, "weights region");
constexpr size_t WS_SSA = 56 * MiB, WS_SSB = 64 * MiB;
constexpr size_t WS_BAR = 62 * MiB, WS_BAR_BYTES = 16384;
constexpr size_t WS_XBB = 72 * MiB;
constexpr size_t WS_PPJ = 264 * MiB;
constexpr size_t WS_BIG = 456 * MiB;
constexpr size_t BIG_Q = 0, BIG_K = 216 * MiB, BIG_VT = 288 * MiB, BIG_LSE = 362 * MiB;
constexpr size_t WS_END = WS_BIG + 528 * MiB;
constexpr size_t OUT_XBA = 0, OUT_PB = 192 * MiB;

constexpr int LDS_BYTES = 147456;
constexpr int NPHASE = 14;

struct Args {
    const float* in[21]; float* out; unsigned char* ws; int ph_lo, ph_hi;
};

#define XB_TMO      128
#define XB_XCNT(j)  (256  + 64 * (j))
#define XB_XSUB(j)  (1280 + 64 * (j))
#define XB_XGEN(j)  (2304 + 64 * (j))
#define XB_TOP      3328
#define XB_TOPGEN   3392
#define XCD_BAR_WORDS 3456
#define XB_SPIN_CAP (1u << 24)
__device__ __forceinline__ unsigned xb_ld(unsigned* p)              { return __hip_atomic_load(p, __ATOMIC_RELAXED, __HIP_MEMORY_SCOPE_AGENT); }
__device__ __forceinline__ unsigned xb_add(unsigned* p, unsigned v) { return __hip_atomic_fetch_add(p, v, __ATOMIC_RELAXED, __HIP_MEMORY_SCOPE_AGENT); }
__device__ __forceinline__ unsigned xb_xcc_id() { return (unsigned)__builtin_amdgcn_s_getreg((3 << 11) | 20) & 0xFu; }
#define XB_SPIN(cond, bar) do { unsigned _sp = 0; while (cond) { __builtin_amdgcn_s_sleep(1); \
    if ((++_sp & 255u) == 0u) { if (xb_ld(&(bar)[XB_TMO])) break; if (_sp > XB_SPIN_CAP) { atomicAdd(&(bar)[XB_TMO], 1u); break; } } } } while (0)
struct XcdBarrier { unsigned* bar; unsigned x; volatile LAS unsigned* st; };
__device__ __forceinline__ XcdBarrier xcd_barrier_post(unsigned* bar, volatile LAS unsigned* st) {
    XcdBarrier b; b.bar = bar; b.x = xb_xcc_id(); b.st = st;
    if (threadIdx.x == 0) (void)xb_add(&bar[XB_XCNT(b.x)], 1u);
    return b;
}
__device__ __forceinline__ void xcd_barrier_complete(unsigned* bar, unsigned x, unsigned& nloc, unsigned& nx) {
    const unsigned G = gridDim.x * gridDim.y * gridDim.z;
    unsigned sum, cnt, mine, sp = 0u;
    for (;;) {
        sum = 0u; cnt = 0u; mine = 0u;
#pragma unroll
        for (unsigned j = 0; j < 16; ++j) { const unsigned c = xb_ld(&bar[XB_XCNT(j)]); sum += c; cnt += (c > 0u) ? 1u : 0u; mine = (j == x) ? c : mine; }
        if (sum == G) break;
        __builtin_amdgcn_s_sleep(1);
        if ((++sp & 255u) == 0u) { if (xb_ld(&bar[XB_TMO])) break; if (sp > XB_SPIN_CAP) { atomicAdd(&bar[XB_TMO], 1u); break; } }
    }
    nloc = mine > 0u ? mine : 1u; nx = cnt > 0u ? cnt : 1u;
}
__device__ __forceinline__ void xcd_barrier(const XcdBarrier& b) {
    asm volatile("s_waitcnt vmcnt(0)" ::: "memory");
    __syncthreads();
    if (threadIdx.x == 0) {
        unsigned* bar = b.bar;
        __builtin_amdgcn_s_waitcnt(0);
        unsigned nloc = b.st[0], nx = b.st[1];
        if (nloc == 0u) { xcd_barrier_complete(bar, b.x, nloc, nx); b.st[0] = nloc; b.st[1] = nx; }
        const unsigned old = xb_add(&bar[XB_XSUB(b.x)], 1u);
        const unsigned gen = old / nloc;
        if (old + 1u == (gen + 1u) * nloc) {
            __builtin_amdgcn_fence(__ATOMIC_RELEASE, "agent");
            asm volatile("s_waitcnt vmcnt(0)" ::: "memory");
            const unsigned og = xb_add(&bar[XB_TOP], 1u);
            const unsigned tg = og / nx;
            if (og + 1u == (tg + 1u) * nx) xb_add(&bar[XB_TOPGEN], 1u);
            else XB_SPIN(xb_ld(&bar[XB_TOPGEN]) == tg, bar);
            __builtin_amdgcn_fence(__ATOMIC_ACQUIRE, "agent");
            xb_add(&bar[XB_XGEN(b.x)], 1u);
            asm volatile("s_waitcnt vmcnt(0)" ::: "memory");
        } else {
            XB_SPIN(xb_ld(&bar[XB_XGEN(b.x)]) == gen, bar);
            __builtin_amdgcn_fence(__ATOMIC_ACQUIRE, "agent");
            asm volatile("s_waitcnt vmcnt(0)" ::: "memory");
        }
    }
    __syncthreads();
}

#define WSP(T, off) ((T*)(ws + (off)))
template <int LAYER>
__device__ __forceinline__ void run_layer(const Args& args, LAS unsigned char* lds, const XcdBarrier& xbar, int lo, int hi) {
#define IN(k) (lo <= (k) && (k) < hi)
#define SEAM(k) do { if (IN(k) && IN((k) + 1)) xcd_barrier(xbar); } while (0)
    constexpr int pb0 = 1 + LAYER * 6;
    constexpr size_t XCUR_IS_OUT = LAYER == 0;
    if (IN(pb0)) {
        unsigned char* ws = args.ws; asm volatile("" : "+s"(ws));
        const int G = gridDim.x, bx = blockIdx.x;
        bf16_t* xcur = LAYER == 0 ? (bf16_t*)((unsigned char*)args.out + OUT_XBA) : WSP(bf16_t, WS_XBB);
        const float* ss_mix = LAYER == 0 ? WSP(float, WS_SSA) : WSP(float, WS_SSB);
        pg8::StaticOrder S;
        if (LAYER == 0) { pg8::Gemm g{xcur, WSP(bf16_t, W_QKVA), MTOT, 1536, 1024}; S.init(MTOT, 1536, G, bx, 1);
            pg8::EpiQKV<false> E{WSP(bf16_t, WS_BIG + BIG_Q), WSP(bf16_t, WS_BIG + BIG_K), WSP(bf16_t, WS_BIG + BIG_VT), ss_mix, args.in[9], args.in[10]}; pg8::gemm_phase(lds, g, S, E); }
        else { pg8::Gemm g{xcur, WSP(bf16_t, W_QKVB), MTOT, 2048, 1024}; S.init(MTOT, 2048, G, bx, 1);
            pg8::EpiQKV<true> E{WSP(bf16_t, WS_BIG + BIG_Q), WSP(bf16_t, WS_BIG + BIG_K), WSP(bf16_t, WS_BIG + BIG_VT), ss_mix, args.in[14], args.in[15]}; pg8::gemm_phase(lds, g, S, E); }
        { const bf16_t* pb = (const bf16_t*)((unsigned char*)args.out + OUT_PB) + (size_t)LAYER * MTOT * PLE;
            pg8::Gemm g{pb, WSP(bf16_t, W_PP) + (size_t)LAYER * 1024 * 256, MTOT, 1024, 256}; S.init(MTOT, 1024, G, bx);
            pg8::EpiPlain E{WSP(bf16_t, WS_PPJ), DM}; pg8::gemm_phase(lds, g, S, E); }
    }
    SEAM(pb0);
    if (IN(pb0 + 1)) {
        unsigned char* ws = args.ws; asm volatile("" : "+s"(ws));
        int tid = threadIdx.x; asm volatile("" : "+v"(tid));
        const int lane = tid & 63, wave = __builtin_amdgcn_readfirstlane(tid >> 6);
        const int G = gridDim.x, bx = blockIdx.x, vcu = (G % 8 == 0) ? (bx % 8) * (G / 8) + bx / 8 : bx;
        bf16_t* Obuf = LAYER == 0 ? WSP(bf16_t, WS_XBB) : (bf16_t*)((unsigned char*)args.out + OUT_XBA);
        AttnP P{WSP(bf16_t, WS_BIG + BIG_Q), Obuf, WSP(bf16_t, WS_BIG + BIG_K), WSP(bf16_t, WS_BIG + BIG_VT), WSP(float, WS_BIG + BIG_LSE), args.in[11], LAYER == 0 ? args.in[9] : args.in[14], LAYER == 0 ? args.in[10] : args.in[15]};
        attn_phase<LAYER == 1>(P, lds, vcu, G, wave, lane);
#if defined(PROBE_DUP_ATTN)
        attn_phase<LAYER == 1>(P, lds, vcu, G, wave, lane);
#endif
        __syncthreads();
    }
    SEAM(pb0 + 1);
    constexpr int pw = pb0 + 2 + LAYER;
    if (LAYER == 1) {
        if (IN(pb0 + 2)) {
            unsigned char* ws = args.ws; asm volatile("" : "+s"(ws));
            int tid = threadIdx.x; asm volatile("" : "+v"(tid));
            const int lane = tid & 63, wave = __builtin_amdgcn_readfirstlane(tid >> 6);
            const int G = gridDim.x, bx = blockIdx.x, vcu = (G % 8 == 0) ? (bx % 8) * (G / 8) + bx / 8 : bx;
            combine_phase((bf16_t*)((unsigned char*)args.out + OUT_XBA), WSP(float, WS_BIG + BIG_LSE), vcu * 8 + wave, G * 8, lane); __syncthreads(); }
        SEAM(pb0 + 2);
    }
    if (IN(pw)) {
        unsigned char* ws = args.ws; asm volatile("" : "+s"(ws));
        const int G = gridDim.x, bx = blockIdx.x;
        bf16_t* xcur = LAYER == 0 ? (bf16_t*)((unsigned char*)args.out + OUT_XBA) : WSP(bf16_t, WS_XBB);
        float* ss_ffn = LAYER == 0 ? WSP(float, WS_SSB) : WSP(float, WS_SSA);
        pg8::StaticOrder S; S.init(MTOT, 1024, G, bx, LAYER == 0 ? 1 : 0);
        pg8::Gemm g{LAYER == 0 ? WSP(bf16_t, WS_XBB) : (bf16_t*)((unsigned char*)args.out + OUT_XBA), LAYER == 0 ? WSP(bf16_t, W_OA) : WSP(bf16_t, W_OB), MTOT, 1024, LAYER == 0 ? 1024 : 1152};
        pg8::EpiResid E{xcur, ss_ffn}; pg8::gemm_phase(lds, g, S, E);
    }
    SEAM(pw);
    if (IN(pw + 1)) {
        unsigned char* ws = args.ws; asm volatile("" : "+s"(ws));
        const int G = gridDim.x, bx = blockIdx.x;
        bf16_t* xcur = LAYER == 0 ? (bf16_t*)((unsigned char*)args.out + OUT_XBA) : WSP(bf16_t, WS_XBB);
        const float* ss_ffn = LAYER == 0 ? WSP(float, WS_SSB) : WSP(float, WS_SSA);
        pg8::StaticOrder S; S.init(MTOT, 5632, G, bx, LAYER == 0 ? 0 : 1);
        pg8::Gemm g{xcur, WSP(bf16_t, W_GU) + (size_t)LAYER * 5632 * 1024, MTOT, 5632, 1024};
        pg8::EpiGU E{WSP(bf16_t, WS_BIG), ss_ffn}; pg8::gemm_phase(lds, g, S, E);
#if defined(PROBE_DUP_GU0)
        if (LAYER == 0) { pg8::gemm_phase(lds, g, S, E); }
#endif
    }
    SEAM(pw + 1);
    if (IN(pw + 2)) {
        unsigned char* ws = args.ws; asm volatile("" : "+s"(ws));
        const int G = gridDim.x, bx = blockIdx.x;
        bf16_t* xcur = LAYER == 0 ? (bf16_t*)((unsigned char*)args.out + OUT_XBA) : WSP(bf16_t, WS_XBB);
        float* ss_ple = LAYER == 0 ? WSP(float, WS_SSA) : WSP(float, WS_SSB);
        pg8::StaticOrder S; S.init(MTOT, 1024, G, bx, LAYER == 0 ? 1 : 0);
        pg8::Gemm g{WSP(bf16_t, WS_BIG), WSP(bf16_t, W_DN) + (size_t)LAYER * 1024 * FFN, MTOT, 1024, FFN};
        pg8::EpiResid E{xcur, ss_ple}; pg8::gemm_phase(lds, g, S, E);
    }
    SEAM(pw + 2);
    if (IN(pw + 3)) {
        unsigned char* ws = args.ws; asm volatile("" : "+s"(ws));
        const int G = gridDim.x, bx = blockIdx.x;
        bf16_t* xcur = LAYER == 0 ? (bf16_t*)((unsigned char*)args.out + OUT_XBA) : WSP(bf16_t, WS_XBB);
        const float* ss_ple = LAYER == 0 ? WSP(float, WS_SSA) : WSP(float, WS_SSB);
        pg8::StaticOrder S; S.init(MTOT, 1024, G, bx, LAYER == 0 ? 0 : 1);
        pg8::Gemm g{xcur, WSP(bf16_t, W_PG) + (size_t)LAYER * 1024 * 1024, MTOT, 1024, 1024};
        if (LAYER == 0) { pg8::EpiPLE<false> E{xcur, WSP(bf16_t, WS_XBB), WSP(bf16_t, WS_PPJ), ss_ple, WSP(float, WS_SSB), nullptr}; pg8::gemm_phase(lds, g, S, E); }
        else { pg8::EpiPLE<true> E{xcur, nullptr, WSP(bf16_t, WS_PPJ), ss_ple, nullptr, args.out}; pg8::gemm_phase(lds, g, S, E); }
#if defined(PROBE_DUP_PLE1)
        if (LAYER == 1) { pg8::EpiPLE<true> E{xcur, nullptr, WSP(bf16_t, WS_PPJ), ss_ple, nullptr, args.out}; pg8::gemm_phase(lds, g, S, E); }
#endif
    }
    if (LAYER == 0) SEAM(pw + 3);
#undef IN
#undef SEAM
}

__device__ __forceinline__ void prologue_phase(const Args& args, LAS unsigned char* lds) {
    unsigned char* ws = args.ws; unsigned char* ob = (unsigned char*)args.out;
    int tid = threadIdx.x; asm volatile("" : "+v"(tid));
    const int lane = tid & 63, wave = __builtin_amdgcn_readfirstlane(tid >> 6);
    const int G = gridDim.x, bx = blockIdx.x, vcu = (G % 8 == 0) ? (bx % 8) * (G / 8) + bx / 8 : bx;
    const int gw = vcu * 8 + wave, ngw = G * 8;
    const float* x_prompt = args.in[0]; const float* x_sample = args.in[1]; const float* p_prompt = args.in[2]; const float* p_sample = args.in[3];
    const float* norm_mix = args.in[4]; const float* norm_ffn = args.in[5]; const float* norm_ple = args.in[6];
    bf16_t* xbA = (bf16_t*)(ob + OUT_XBA); bf16_t* pb = (bf16_t*)(ob + OUT_PB); float* ssA = WSP(float, WS_SSA);
    LAS float* scr = (LAS float*)(lds + wave * 16384);
    constexpr int I_QA = 16 * 48, I_QB = 16 * 64, I_OA = 16 * 32, I_OB = 18 * 32, I_GU = 16 * 176, I_DN = 44 * 32, I_PG = 16 * 32, I_PP = 4 * 32;
    constexpr int NITEMS = I_QA + I_QB + I_OA + I_OB + 2 * I_GU + 2 * I_DN + 2 * I_PG + 2 * I_PP;
#pragma unroll 1
    for (int it = gw; it < NITEMS; it += ngw) {
        int r = it;
        const float* W0; const float* W1 = nullptr; int K, Nsrc, mode, nsg; bf16_t* WT; const float* gain = nullptr;
        if (r < I_QA) { W0 = args.in[7]; K = 1024; Nsrc = 1536; WT = WSP(bf16_t, W_QKVA); mode = 1; gain = norm_mix; nsg = 48; }
        else if ((r -= I_QA) < I_QB) { W0 = args.in[12]; K = 1024; Nsrc = 1920; WT = WSP(bf16_t, W_QKVB); mode = 1; gain = norm_mix + 1024; nsg = 64; }
        else if ((r -= I_QB) < I_OA) { W0 = args.in[8]; K = 1024; Nsrc = 1024; WT = WSP(bf16_t, W_OA); mode = 0; nsg = 32; }
        else if ((r -= I_OA) < I_OB) { W0 = args.in[13]; K = 1152; Nsrc = 1024; WT = WSP(bf16_t, W_OB); mode = 0; nsg = 32; }
        else if ((r -= I_OB) < 2 * I_GU) { const int l = r / I_GU; r -= l * I_GU; W0 = args.in[16] + (size_t)l * 1024 * FFN; W1 = args.in[17] + (size_t)l * 1024 * FFN; K = 1024; Nsrc = FFN;
            WT = WSP(bf16_t, W_GU) + (size_t)l * 5632 * 1024; mode = 2; gain = norm_ffn + l * 1024; nsg = 176; }
        else if ((r -= 2 * I_GU) < 2 * I_DN) { const int l = r / I_DN; r -= l * I_DN; W0 = args.in[18] + (size_t)l * FFN * 1024; K = FFN; Nsrc = 1024; WT = WSP(bf16_t, W_DN) + (size_t)l * 1024 * FFN; mode = 0; nsg = 32; }
        else if ((r -= 2 * I_DN) < 2 * I_PG) { const int l = r / I_PG; r -= l * I_PG; W0 = args.in[19] + (size_t)l * 1024 * 1024; K = 1024; Nsrc = 1024; WT = WSP(bf16_t, W_PG) + (size_t)l * 1024 * 1024; mode = 0; gain = norm_ple + l * 1024; nsg = 32; }
        else { r -= 2 * I_PG; const int l = r / I_PP; r -= l * I_PP; W0 = args.in[20] + (size_t)l * 256 * 1024; K = 256; Nsrc = 1024; WT = WSP(bf16_t, W_PP) + (size_t)l * 1024 * 256; mode = 0; nsg = 32; }
        p0_item(W0, W1, K, Nsrc, WT, mode, gain, scr, r, nsg, lane);
    }
#pragma unroll 1
    for (int r0 = gw * 8; r0 < 2 * MTOT; r0 += ngw * 8) {
        f32x4 v[8];
#pragma unroll
        for (int r = 0; r < 8; ++r) { const int rr = r0 + r; const int l = rr >= MTOT ? 1 : 0, m = rr - l * MTOT;
            const float* pr = m < MPROMPT ? p_prompt + ((size_t)l * MPROMPT + m) * PLE : p_sample + ((size_t)l * (MTOT - MPROMPT) + (m - MPROMPT)) * PLE;
            v[r] = __builtin_nontemporal_load((const f32x4*)pr + lane); }
#pragma unroll
        for (int r = 0; r < 8; ++r) { u32x2 w; w.x = cvt_pk_bf16(v[r].x, v[r].y); w.y = cvt_pk_bf16(v[r].z, v[r].w); ((u32x2*)(pb + (size_t)(r0 + r) * PLE))[lane] = w; }
    }
#pragma unroll 1
    for (int m0 = gw * 4; m0 < MTOT; m0 += ngw * 4) {
        f32x4 v[4][4];
#pragma unroll
        for (int r = 0; r < 4; ++r) { const int m = m0 + r; const float* xr = m < MPROMPT ? x_prompt + (size_t)m * DM : x_sample + (size_t)(m - MPROMPT) * DM; const f32x4* xv = (const f32x4*)xr + lane;
#pragma unroll
            for (int j = 0; j < 4; ++j) v[r][j] = __builtin_nontemporal_load(xv + 64 * j); }
#pragma unroll
        for (int r = 0; r < 4; ++r) { const int m = m0 + r; float s = 0.f;
#pragma unroll
            for (int j = 0; j < 4; ++j) s += (v[r][j].x * v[r][j].x + v[r][j].y * v[r][j].y) + (v[r][j].z * v[r][j].z + v[r][j].w * v[r][j].w);
            s = wave_sum(s);
            u32x2* o8 = (u32x2*)(xbA + (size_t)m * DM) + lane;
#pragma unroll
            for (int j = 0; j < 4; ++j) { u32x2 w; w.x = cvt_pk_bf16(v[r][j].x, v[r][j].y); w.y = cvt_pk_bf16(v[r][j].z, v[r][j].w); o8[64 * j] = w; }
            if (lane < 16) ssA[(size_t)m * 16 + lane] = lane == 0 ? s : 0.f; }
    }
    __syncthreads();
}

__global__ void __launch_bounds__(512, 2) fwd_kernel(Args args) {
    extern __shared__ __attribute__((aligned(16))) unsigned char lds_raw[];
    LAS unsigned char* lds = (LAS unsigned char*)lds_raw;
    cg::grid_group grid = cg::this_grid();
    const int lo = args.ph_lo, hi = args.ph_hi;
    volatile LAS unsigned* bst = (volatile LAS unsigned*)(lds + (LDS_BYTES - 64));
    if (threadIdx.x < 2) bst[threadIdx.x] = 0u;
    __syncthreads();
    const XcdBarrier xbar = xcd_barrier_post((unsigned*)(args.ws + WS_BAR), bst);
    if (lo <= 0 && 0 < hi) prologue_phase(args, lds);
    if (lo <= 0 && 1 < hi) grid.sync();
    run_layer<0>(args, lds, xbar, lo, hi);
    run_layer<1>(args, lds, xbar, lo, hi);
}

extern "C" void kernel_launch(void* const* d_in, const int* in_sizes, int n_in, void* d_out, int out_size, void* d_ws, size_t ws_size, hipStream_t stream) {
    static int grid = 0;
    if (grid == 0) {
        if (n_in != 21 || out_size != MTOT * DM || ws_size < WS_END) { fprintf(stderr, "kernel_launch: unexpected sizes (n_in %d out %d ws %zu, need %zu)\n", n_in, out_size, ws_size, (size_t)WS_END); grid = -1; return; }
        int dev = 0, cus = 0, per_cu = 0;
        (void)hipGetDevice(&dev); (void)hipDeviceGetAttribute(&cus, hipDeviceAttributeMultiprocessorCount, dev);
        if (hipFuncSetAttribute((const void*)fwd_kernel, hipFuncAttributeMaxDynamicSharedMemorySize, LDS_BYTES) != hipSuccess) { fprintf(stderr, "kernel_launch: hipFuncSetAttribute failed\n"); grid = -1; return; }
        (void)hipOccupancyMaxActiveBlocksPerMultiprocessor(&per_cu, (const void*)fwd_kernel, 512, LDS_BYTES);
        (void)hipGetLastError();
        if (per_cu < 1) per_cu = 1;
        grid = cus;
    }
    if (grid < 0) return;
    Args a{};
    for (int i = 0; i < 21; ++i) a.in[i] = (const float*)d_in[i];
    a.out = (float*)d_out; a.ws = (unsigned char*)d_ws;
#if MK_SINGLE
    if (hipMemsetAsync((char*)d_ws + WS_BAR, 0, WS_BAR_BYTES, stream) != hipSuccess) { fprintf(stderr, "kernel_launch: hipMemsetAsync failed\n"); return; }
    a.ph_lo = 0; a.ph_hi = NPHASE;
    void* kargs[] = {&a};
    hipError_t e = hipLaunchCooperativeKernel((const void*)fwd_kernel, dim3(grid), dim3(512), kargs, LDS_BYTES, stream);
    if (e != hipSuccess) fprintf(stderr, "cooperative launch failed: %s (grid %d)\n", hipGetErrorString(e), grid);
#else
    for (int k = 0; k < NPHASE; ++k) {
        a.ph_lo = k; a.ph_hi = k + 1;
        hipLaunchKernelGGL(fwd_kernel, dim3(grid), dim3(512), LDS_BYTES, stream, a);
    }
#endif
}
```

```cpp
#include <hip/hip_runtime.h>
#include <hip/hip_cooperative_groups.h>
#include <cstdio>
#include <cstdint>
#include <cmath>
namespace cg = cooperative_groups;

#ifndef MK_SINGLE
#define MK_SINGLE 1
#endif

#define LAS __attribute__((address_space(3)))
typedef unsigned short bf16_t;
typedef short bf16x8 __attribute__((ext_vector_type(8)));
typedef float f32x4 __attribute__((ext_vector_type(4)));
typedef float f32x16 __attribute__((ext_vector_type(16)));
typedef unsigned u32x4 __attribute__((ext_vector_type(4)));
typedef unsigned u32x2 __attribute__((ext_vector_type(2)));

constexpr int DM = 1024, MTOT = 98304, MPROMPT = 65536, LP = 8192, LS = 2048;
constexpr int FFN = 2816, PLE = 256;
constexpr int VTP = MTOT + 128;
constexpr int A_NQ = 16, A_NKV = 4, B_NQ = 18, B_NKV = 6;
constexpr float EPS = 1e-6f, LOG2E = 1.4426950408889634f;

typedef float f32x2_t __attribute__((ext_vector_type(2))); typedef __bf16 bf16x2_t __attribute__((ext_vector_type(2)));
__device__ __forceinline__ unsigned cvt_pk_bf16(float lo, float hi) { f32x2_t v = {lo, hi}; bf16x2_t b = __builtin_convertvector(v, bf16x2_t); return __builtin_bit_cast(unsigned, b); }
__device__ __forceinline__ float bflo(unsigned w) { return __uint_as_float(w << 16); }
__device__ __forceinline__ float bfhi(unsigned w) { return __uint_as_float(w & 0xffff0000u); }
__device__ __forceinline__ float wave_sum(float v) {
#pragma unroll
    for (int o = 1; o < 64; o <<= 1) v += __shfl_xor(v, o);
    return v;
}
__device__ __forceinline__ float row_rstd(const float* ss, int row) {
    const f32x4* p = (const f32x4*)(ss + (size_t)row * 16);
    const f32x4 a = p[0], b = p[1], c = p[2], d = p[3];
    const float s = (((a.x + a.y) + (a.z + a.w)) + ((b.x + b.y) + (b.z + b.w))) + (((c.x + c.y) + (c.z + c.w)) + ((d.x + d.y) + (d.z + d.w)));
    return rsqrtf(s * (1.0f / 1024.0f) + EPS);
}

__device__ __forceinline__ void rows_rstd8(const float* ss, int row0, int lane, float (&rs)[8]) {
    const int fq = lane >> 4, fr = lane & 15;
    float mine[2];
#pragma unroll
    for (int j = 0; j < 2; ++j) { const int k = 2 * fq + j; mine[j] = row_rstd(ss, row0 + 128 * (k >> 2) + 16 * (k & 3)); }
#pragma unroll
    for (int k = 0; k < 8; ++k) rs[k] = __shfl(mine[k & 1], fr + 16 * (k >> 1));
}

namespace pg8 {
constexpr int BM = 256, BK = 64, HALF = 128, HTB = HALF * BK * 2, STAGE_BYTES = 8 * HTB, NXCD = 8, WGM = 8;
__host__ __device__ __forceinline__ int lds_byte(int r, int c) { const int st = (r >> 4) * 2 + (c >> 5), rr = r & 15, cc = c & 31, ob = rr * 64 + cc * 2; return st * 1024 + (ob ^ (((ob >> 9) & 1) << 5)); }
__host__ __device__ __forceinline__ void stage_rc(int b, int& R, int& C) { const int st = b / 1024, sb = b % 1024, swz = sb ^ (((sb >> 9) & 1) << 5); R = (st >> 1) * 16 + swz / 64; C = (st & 1) * 32 + (swz % 64) / 2; }
__host__ __device__ __forceinline__ int perm32(int rho) { const int n = rho >> 4, i = rho & 15; return 8 * (i >> 2) + 4 * n + (i & 3); }

struct Unit { int pm, pn; };
struct Gemm { const bf16_t* A; const bf16_t* Bt; int M, N, K; };

struct StaticOrder {
    int nM, nN, nwg, G, c, rev;
    __host__ __device__ void init(int M, int N, int G_, int c_, int rev_ = 0) { nM = M / BM; nN = N / BM; nwg = nM * nN; G = G_; c = c_; rev = rev_; }
    __host__ __device__ bool next(int i, Unit& u) const {
        const long L = (long)i * G + c; if (L >= nwg) return false;
        int wgid = (int)L; { const int q = nwg / NXCD, r = nwg % NXCD, xcd = wgid % NXCD, off = wgid / NXCD; wgid = (xcd < r ? xcd * (q + 1) : r * (q + 1) + (xcd - r) * q) + off; }
        const int nig = WGM * nN, gid = wgid / nig, fm = gid * WGM, gsz = (nM - fm) < WGM ? (nM - fm) : WGM;
        u.pm = fm + ((wgid % nig) % gsz); u.pn = (wgid % nig) / gsz; if (rev) u.pm = nM - 1 - u.pm; return true;
    }
};

template <class Epi, class Sched, bool ALIGN_EPI = true>
__device__ __forceinline__ void gemm_phase(LAS unsigned char* lds, const Gemm g, const Sched& S, const Epi& E) {
    int tid_ = threadIdx.x; asm volatile("" : "+v"(tid_));
    const int tid = tid_, wid = __builtin_amdgcn_readfirstlane(tid >> 6), lane = tid & 63, wr = wid >> 2, wc = wid & 3, fr = lane & 15, fq = lane >> 4;
    int K_ = g.K; asm volatile("" : "+s"(K_));
    const int K = K_, nt = K / BK;
    unsigned voffA[2], voffB[2];
#pragma unroll
    for (int i = 0; i < 2; ++i) { int R, C; stage_rc(tid * 16 + i * 8192, R, C); const int Rb = (R & ~31) + perm32(R & 31);
        voffA[i] = (unsigned)(R * K + C) * 2u; voffB[i] = (unsigned)(Rb * K + C) * 2u; }
    const size_t kstep = (size_t)(BK * 2);
    const size_t hstep = (size_t)HALF * K * 2;
    const size_t tstep = 2 * hstep;
    const unsigned ldsw = (unsigned)wid * 1024u;
    const int aoff = lds_byte(wr * 64 + fr, fq * 8), boff = lds_byte(wc * 32 + fr, fq * 8);
#define PG8_SA(b, h) (((b) * 2 + (h)) * HTB)
#define PG8_SB(b, h) ((4 + (b) * 2 + (h)) * HTB)
#define PG8_STAGE(bufoff, gbase, voff) do { _Pragma("unroll") for (int _i = 0; _i < 2; ++_i) \
        __builtin_amdgcn_global_load_lds((const unsigned*)((const char*)(gbase) + (voff)[_i]), (LAS unsigned*)(lds + (bufoff) + ldsw + _i * 8192), 16, 0, 0); } while (0)
#define PG8_LDA(dst, b, h) do { _Pragma("unroll") for (int m = 0; m < 4; ++m) _Pragma("unroll") for (int k = 0; k < 2; ++k) dst[m][k] = *(const LAS bf16x8*)(lds + PG8_SA(b, h) + aoff + m * 2048 + k * 1024); } while (0)
#define PG8_LDB(dst, b, h) do { _Pragma("unroll") for (int n = 0; n < 2; ++n) _Pragma("unroll") for (int k = 0; k < 2; ++k) dst[n][k] = *(const LAS bf16x8*)(lds + PG8_SB(b, h) + boff + n * 2048 + k * 1024); } while (0)
#define PG8_MMA(ai, bj, At, Bt) do { __builtin_amdgcn_s_setprio(1); _Pragma("unroll") for (int m = 0; m < 4; ++m) _Pragma("unroll") for (int n = 0; n < 2; ++n) _Pragma("unroll") for (int k = 0; k < 2; ++k) \
        acc[ai][bj][m][n] = __builtin_amdgcn_mfma_f32_16x16x32_bf16(Bt[n][k], At[m][k], acc[ai][bj][m][n], 0, 0, 0); __builtin_amdgcn_s_setprio(0); } while (0)
#define PG8_WAIT_V(n) asm volatile("s_waitcnt vmcnt(" #n ")" ::: "memory")
#define PG8_WAIT_L(n) asm volatile("s_waitcnt lgkmcnt(" #n ")" ::: "memory")
#define PG8_BAR __builtin_amdgcn_s_barrier()
#define PG8_SCHED __builtin_amdgcn_sched_barrier(0)
    Unit cur, nxt; int ui = 0;
    if (!S.next(0, cur)) return;
    f32x4 acc[2][2][4][2];
#pragma unroll
    for (int a = 0; a < 2; ++a)
#pragma unroll
        for (int b = 0; b < 2; ++b)
#pragma unroll
            for (int m = 0; m < 4; ++m)
#pragma unroll
                for (int n = 0; n < 2; ++n) acc[a][b][m][n] = (f32x4){0.f, 0.f, 0.f, 0.f};
    bf16x8 At[4][2], B0[2][2], B1[2][2];
    const char* cA = (const char*)g.A + (size_t)cur.pm * tstep; const char* cB = (const char*)g.Bt + (size_t)cur.pn * tstep;
    PG8_STAGE(PG8_SB(0, 0), cB, voffB); PG8_STAGE(PG8_SB(0, 1), cB + hstep, voffB); PG8_STAGE(PG8_SA(0, 0), cA, voffA); PG8_STAGE(PG8_SA(0, 1), cA + hstep, voffA);
    if (wr == 1) PG8_BAR;
    PG8_WAIT_V(2); PG8_BAR;
    PG8_STAGE(PG8_SB(1, 0), cB + kstep, voffB); PG8_STAGE(PG8_SA(1, 0), cA + kstep, voffA); PG8_STAGE(PG8_SB(1, 1), cB + hstep + kstep, voffB);
    PG8_WAIT_V(6); PG8_BAR;
    for (;;) {
        const bool has_next = S.next(ui + 1, nxt);
        const char* nA = has_next ? (const char*)g.A + (size_t)nxt.pm * tstep : cA; const char* nB = has_next ? (const char*)g.Bt + (size_t)nxt.pn * tstep : cB;
        for (int t = 0; t < nt; t += 2) {
            const bool last = (t == nt - 2);
            const char* a1 = cA + (size_t)(t + 1) * kstep;
            const char* a2 = last ? nA : cA + (size_t)(t + 2) * kstep; const char* b2 = last ? nB : cB + (size_t)(t + 2) * kstep;
            const char* a3 = a2 + kstep; const char* b3 = b2 + kstep;
            PG8_LDB(B0, 0, 0); PG8_LDB(B1, 0, 1); PG8_SCHED; PG8_LDA(At, 0, 0); PG8_STAGE(PG8_SA(1, 1), a1 + hstep, voffA);
            PG8_WAIT_V(8); PG8_WAIT_L(0); PG8_BAR; PG8_MMA(0, 0, At, B0); PG8_MMA(0, 1, At, B1); PG8_BAR; PG8_SCHED;
            PG8_LDA(At, 0, 1); PG8_STAGE(PG8_SB(0, 0), b2, voffB); PG8_STAGE(PG8_SB(0, 1), b2 + hstep, voffB); PG8_STAGE(PG8_SA(0, 0), a2, voffA);
            PG8_WAIT_V(8); PG8_WAIT_L(0); PG8_BAR; PG8_MMA(1, 0, At, B0); PG8_MMA(1, 1, At, B1); PG8_BAR; PG8_SCHED;
            PG8_LDB(B0, 1, 0); PG8_LDB(B1, 1, 1); PG8_SCHED; PG8_LDA(At, 1, 0); PG8_STAGE(PG8_SA(0, 1), a2 + hstep, voffA);
            PG8_WAIT_V(8); PG8_WAIT_L(0); PG8_BAR; PG8_MMA(0, 0, At, B0); PG8_MMA(0, 1, At, B1); PG8_BAR; PG8_SCHED;
            PG8_LDA(At, 1, 1); PG8_STAGE(PG8_SB(1, 0), b3, voffB); PG8_STAGE(PG8_SB(1, 1), b3 + hstep, voffB); PG8_STAGE(PG8_SA(1, 0), a3, voffA);
            PG8_WAIT_V(8); PG8_WAIT_L(0); PG8_BAR; PG8_MMA(1, 0, At, B0); PG8_MMA(1, 1, At, B1); PG8_BAR; PG8_SCHED;
        }
        if constexpr (ALIGN_EPI) { if (wr == 0) PG8_BAR; }
        E(acc, cur, wr, wc, fr, fq);
        if (!has_next) break;
#pragma unroll
        for (int a = 0; a < 2; ++a)
#pragma unroll
            for (int b = 0; b < 2; ++b)
#pragma unroll
                for (int m = 0; m < 4; ++m)
#pragma unroll
                    for (int n = 0; n < 2; ++n) acc[a][b][m][n] = (f32x4){0.f, 0.f, 0.f, 0.f};
        cur = nxt; cA = nA; cB = nB; ++ui;
        if constexpr (ALIGN_EPI) { if (wr == 1) PG8_BAR; }
    }
    PG8_WAIT_V(0);
    if constexpr (!ALIGN_EPI) { if (wr == 0) PG8_BAR; }
    PG8_BAR;
#undef PG8_SA
#undef PG8_SB
#undef PG8_STAGE
#undef PG8_LDA
#undef PG8_LDB
#undef PG8_MMA
#undef PG8_WAIT_V
#undef PG8_WAIT_L
#undef PG8_BAR
#undef PG8_SCHED
}

struct EpiPlain {
    bf16_t* O; int ldc;
    __device__ __forceinline__ void operator()(const f32x4 (&acc)[2][2][4][2], const Unit& u, int wr, int wc, int fr, int fq) const {
        const int row0 = u.pm * BM + wr * 64 + fr, col0 = u.pn * BM + wc * 32 + 8 * fq;
#pragma unroll
        for (int ai = 0; ai < 2; ++ai)
#pragma unroll
            for (int m = 0; m < 4; ++m) { bf16_t* rowp = O + (size_t)(row0 + ai * HALF + m * 16) * ldc + col0;
#pragma unroll
                for (int bj = 0; bj < 2; ++bj) { const f32x4 v0 = acc[ai][bj][m][0], v1 = acc[ai][bj][m][1];
                    u32x4 w; w.x = cvt_pk_bf16(v0[0], v0[1]); w.y = cvt_pk_bf16(v0[2], v0[3]); w.z = cvt_pk_bf16(v1[0], v1[1]); w.w = cvt_pk_bf16(v1[2], v1[3]);
                    *(u32x4*)(rowp + bj * HALF) = w; } }
    }
};

template <bool LB> struct EpiQKV {
    bf16_t* Q; bf16_t* Kb; bf16_t* VT; const float* ss; const float* qgain; const float* kgain;
    __device__ __forceinline__ void operator()(const f32x4 (&acc)[2][2][4][2], const Unit& u, int wr, int wc, int fr, int fq) const {
        constexpr int NQ = LB ? B_NQ : A_NQ, NKV = LB ? B_NKV : A_NKV, LDQ = NQ * 64, LDK = NKV * 64;
        const int head = u.pn * 4 + wc;
        if (head >= NQ + 2 * NKV) return;
        const int kind = head < NQ ? 0 : (head < NQ + NKV ? 1 : 2);
        const int row0 = u.pm * BM + wr * 64 + fr;
        if (kind < 2) {
            const float* gp = (kind == 0 ? qgain : kgain) + 8 * fq;
            f32x4 gv[2][2];
#pragma unroll
            for (int bj = 0; bj < 2; ++bj)
#pragma unroll
                for (int n = 0; n < 2; ++n) gv[bj][n] = *(const f32x4*)(gp + 32 * bj + 4 * n);
            const float post = kind == 0 ? 0.125f * LOG2E : 1.0f;
            bf16_t* base = kind == 0 ? (Q + head * 64 + 8 * fq) : (Kb + (head - NQ) * 64 + 8 * fq);
            const int ld = kind == 0 ? LDQ : LDK;
            float rs8[8]; rows_rstd8(ss, row0, fq * 16 + fr, rs8);
#pragma unroll
            for (int ai = 0; ai < 2; ++ai)
#pragma unroll
                for (int m = 0; m < 4; ++m) {
                    const int row = row0 + ai * HALF + m * 16;
                    float s2 = 0.f;
#pragma unroll
                    for (int bj = 0; bj < 2; ++bj)
#pragma unroll
                        for (int n = 0; n < 2; ++n) { const f32x4 a = acc[ai][bj][m][n]; s2 += (a[0] * a[0] + a[1] * a[1]) + (a[2] * a[2] + a[3] * a[3]); }
                    s2 += __shfl_xor(s2, 16); s2 += __shfl_xor(s2, 32);
                    const float rs = rs8[ai * 4 + m];
                    const float sc = rs * rsqrtf(rs * rs * s2 * (1.0f / 64.0f) + EPS) * post;
                    bf16_t* rowp = base + (size_t)row * ld;
#pragma unroll
                    for (int bj = 0; bj < 2; ++bj) { const f32x4 v0 = acc[ai][bj][m][0] * sc * gv[bj][0], v1 = acc[ai][bj][m][1] * sc * gv[bj][1];
                        u32x4 w; w.x = cvt_pk_bf16(v0[0], v0[1]); w.y = cvt_pk_bf16(v0[2], v0[3]); w.z = cvt_pk_bf16(v1[0], v1[1]); w.w = cvt_pk_bf16(v1[2], v1[3]);
                        *(u32x4*)(rowp + 32 * bj) = w; }
                }
        } else {
            bf16_t* base = VT + (head - NQ - NKV) * 64 + 8 * fq;
            float rs8[8]; rows_rstd8(ss, row0, fq * 16 + fr, rs8);
#pragma unroll
            for (int ai = 0; ai < 2; ++ai)
#pragma unroll
                for (int m = 0; m < 4; ++m) {
                    const int row = row0 + ai * HALF + m * 16;
                    const float rs = rs8[ai * 4 + m];
                    bf16_t* rowp = base + (size_t)row * LDK;
#pragma unroll
                    for (int bj = 0; bj < 2; ++bj) { const f32x4 v0 = acc[ai][bj][m][0] * rs, v1 = acc[ai][bj][m][1] * rs;
                        u32x4 w; w.x = cvt_pk_bf16(v0[0], v0[1]); w.y = cvt_pk_bf16(v0[2], v0[3]); w.z = cvt_pk_bf16(v1[0], v1[1]); w.w = cvt_pk_bf16(v1[2], v1[3]);
                        *(u32x4*)(rowp + 32 * bj) = w; }
                }
        }
    }
};

struct EpiResid {
    bf16_t* X; float* ss_out;
    __device__ __forceinline__ void operator()(const f32x4 (&acc)[2][2][4][2], const Unit& u, int wr, int wc, int fr, int fq) const {
        const int row0 = u.pm * BM + wr * 64 + fr, col0 = u.pn * BM + wc * 32 + 8 * fq;
        bf16_t* base = X + (size_t)row0 * DM + col0;
        u32x4 xw[2][4][2];
#pragma unroll
        for (int ai = 0; ai < 2; ++ai)
#pragma unroll
            for (int m = 0; m < 4; ++m)
#pragma unroll
                for (int bj = 0; bj < 2; ++bj) xw[ai][m][bj] = *(const u32x4*)(base + (size_t)(ai * HALF + m * 16) * DM + bj * HALF);
#pragma unroll
        for (int ai = 0; ai < 2; ++ai)
#pragma unroll
            for (int m = 0; m < 4; ++m) { const int row = row0 + ai * HALF + m * 16; bf16_t* rowp = base + (size_t)(ai * HALF + m * 16) * DM; float s = 0.f;
#pragma unroll
                for (int bj = 0; bj < 2; ++bj) { const u32x4 w_ = xw[ai][m][bj]; f32x4 v0 = acc[ai][bj][m][0], v1 = acc[ai][bj][m][1];
                    v0[0] += bflo(w_.x); v0[1] += bfhi(w_.x); v0[2] += bflo(w_.y); v0[3] += bfhi(w_.y); v1[0] += bflo(w_.z); v1[1] += bfhi(w_.z); v1[2] += bflo(w_.w); v1[3] += bfhi(w_.w);
                    s += ((v0[0] * v0[0] + v0[1] * v0[1]) + (v0[2] * v0[2] + v0[3] * v0[3])) + ((v1[0] * v1[0] + v1[1] * v1[1]) + (v1[2] * v1[2] + v1[3] * v1[3]));
                    u32x4 w; w.x = cvt_pk_bf16(v0[0], v0[1]); w.y = cvt_pk_bf16(v0[2], v0[3]); w.z = cvt_pk_bf16(v1[0], v1[1]); w.w = cvt_pk_bf16(v1[2], v1[3]);
                    *(u32x4*)(rowp + bj * HALF) = w; }
                s += __shfl_xor(s, 16); s += __shfl_xor(s, 32);
                if (fq == 0) ss_out[(size_t)row * 16 + u.pn * 4 + wc] = s; }
    }
};

struct EpiGU {
    bf16_t* H; const float* ss;
    __device__ __forceinline__ void operator()(const f32x4 (&acc)[2][2][4][2], const Unit& u, int wr, int wc, int fr, int fq) const {
        const int row0 = u.pm * BM + wr * 64 + fr, col0 = u.pn * HALF + wc * 32 + 8 * fq;
        float rs8[8]; rows_rstd8(ss, row0, fq * 16 + fr, rs8);
#pragma unroll
        for (int ai = 0; ai < 2; ++ai)
#pragma unroll
            for (int m = 0; m < 4; ++m) { const int row = row0 + ai * HALF + m * 16; const float rs = rs8[ai * 4 + m];
                float h[8];
#pragma unroll
                for (int n = 0; n < 2; ++n)
#pragma unroll
                    for (int i = 0; i < 4; ++i) { const float gg = acc[ai][0][m][n][i] * rs, uu = acc[ai][1][m][n][i] * rs;
                        h[4 * n + i] = gg * uu * __builtin_amdgcn_rcpf(1.0f + __builtin_amdgcn_exp2f(-gg * LOG2E)); }
                u32x4 w; w.x = cvt_pk_bf16(h[0], h[1]); w.y = cvt_pk_bf16(h[2], h[3]); w.z = cvt_pk_bf16(h[4], h[5]); w.w = cvt_pk_bf16(h[6], h[7]);
                *(u32x4*)(H + (size_t)row * FFN + col0) = w; }
    }
};

template <bool LAST> struct EpiPLE {
    const bf16_t* Xin; bf16_t* Xout; const bf16_t* PP; const float* ss; float* ss_out; float* out;
    __device__ __forceinline__ void operator()(const f32x4 (&acc)[2][2][4][2], const Unit& u, int wr, int wc, int fr, int fq) const {
        const int row0 = u.pm * BM + wr * 64 + fr, col0 = u.pn * BM + wc * 32 + 8 * fq;
        float rs8[8]; rows_rstd8(ss, row0, fq * 16 + fr, rs8);
#pragma unroll
        for (int ai = 0; ai < 2; ++ai) {
            u32x4 xw[4][2], pw[4][2];
#pragma unroll
            for (int m = 0; m < 4; ++m)
#pragma unroll
                for (int bj = 0; bj < 2; ++bj) { const size_t off = (size_t)(row0 + ai * HALF + m * 16) * DM + col0 + bj * HALF; xw[m][bj] = *(const u32x4*)(Xin + off); pw[m][bj] = *(const u32x4*)(PP + off); }
            asm volatile("" ::: "memory");
#pragma unroll
            for (int m = 0; m < 4; ++m) { const int row = row0 + ai * HALF + m * 16; const float rs = rs8[ai * 4 + m]; const size_t off = (size_t)row * DM + col0; float s = 0.f;
#pragma unroll
                for (int bj = 0; bj < 2; ++bj) { const u32x4 xq_ = xw[m][bj], pq_ = pw[m][bj];
                    float xv[8] = {bflo(xq_.x), bfhi(xq_.x), bflo(xq_.y), bfhi(xq_.y), bflo(xq_.z), bfhi(xq_.z), bflo(xq_.w), bfhi(xq_.w)};
                    const float pv[8] = {bflo(pq_.x), bfhi(pq_.x), bflo(pq_.y), bfhi(pq_.y), bflo(pq_.z), bfhi(pq_.z), bflo(pq_.w), bfhi(pq_.w)};
#pragma unroll
                    for (int n = 0; n < 2; ++n)
#pragma unroll
                        for (int i = 0; i < 4; ++i) { const float a = acc[ai][bj][m][n][i] * rs; const float gate = __builtin_amdgcn_rcpf(1.0f + __builtin_amdgcn_exp2f(-a * LOG2E));
                            xv[4 * n + i] += gate * pv[4 * n + i]; s += xv[4 * n + i] * xv[4 * n + i]; }
                    if (LAST) { *(f32x4*)(out + off + bj * HALF) = (f32x4){xv[0], xv[1], xv[2], xv[3]}; *(f32x4*)(out + off + bj * HALF + 4) = (f32x4){xv[4], xv[5], xv[6], xv[7]}; }
                    else { u32x4 w; w.x = cvt_pk_bf16(xv[0], xv[1]); w.y = cvt_pk_bf16(xv[2], xv[3]); w.z = cvt_pk_bf16(xv[4], xv[5]); w.w = cvt_pk_bf16(xv[6], xv[7]); *(u32x4*)(Xout + off + bj * HALF) = w; } }
                if (!LAST) { s += __shfl_xor(s, 16); s += __shfl_xor(s, 32); if (fq == 0) ss_out[(size_t)row * 16 + u.pn * 4 + wc] = s; } }
        }
    }
};
}

struct AttnP { const bf16_t* Q; bf16_t* O; const bf16_t* Kb; const bf16_t* Vb; float* LSE; const float* sink; const float* qg; const float* kg; };
__device__ __forceinline__ float xhalf_max(float m) { auto rr = __builtin_amdgcn_permlane32_swap(__float_as_uint(m), __float_as_uint(m), false, false); return fmaxf(__uint_as_float(rr[0]), __uint_as_float(rr[1])); }
__device__ __forceinline__ float xhalf_sum(float m) { auto rr = __builtin_amdgcn_permlane32_swap(__float_as_uint(m), __float_as_uint(m), false, false); return __uint_as_float(rr[0]) + __uint_as_float(rr[1]); }

template <bool LB>
__device__ __forceinline__ void attn_phase(const AttnP P, LAS unsigned char* lds, int vcu, int G, int wave, int lane) {
    constexpr int R = LB ? 64 : 128, NT = 2 * R / 32 + 1, TD = R / 32, HPT = LB ? 1 : 2, WPS = LB ? 4 : 8, NR = LB ? 3 : 1;
    constexpr int W = 128 + 2 * R, KP = 144, VPB = (W + 8) * 2, SUBB = W * KP + 64 * VPB;
    constexpr int NBT = LB ? 2304 : 3072;
    constexpr int LDQ = (LB ? B_NQ : A_NQ) * 64, LDK = (LB ? B_NKV : A_NKV) * 64;
    static_assert((8 / WPS) * SUBB <= 147456, "attention LDS");
    const int NI = (NBT + G - 1) / G;
    const int q = lane & 31, hi = lane >> 5;
    const int sub = wave / WPS, wsub = wave % WPS;
    const float xq = (float)(4 * hi - q);
    float bnd; { float gq = fabsf(P.qg[lane]), gk = fabsf(P.kg[lane]);
#pragma unroll
        for (int o = 1; o < 64; o <<= 1) { gq = fmaxf(gq, __shfl_xor(gq, o)); gk = fmaxf(gk, __shfl_xor(gk, o)); }
        bnd = 8.0f * LOG2E * 1.02f * gq * gk; }
    const int vro0 = q * VPB, vro1 = (32 + q) * VPB, dsw0 = q & ~7, dsw1 = 32 + (q & ~7);
#pragma unroll 1
    for (int it = 0; it < NI; ++it) {
        const int bt = it * G + vcu; if (bt >= NBT) break;
        const int st = LB ? bt * 2 + sub : bt;
        int hq0, kvh, ld, blk;
        if (LB) { const int kvc = st & 1, tb = st >> 1, g = tb / 768; blk = tb - g * 768; kvh = 2 * g + kvc; hq0 = 6 * g; ld = 2 * g; }
        else { kvh = st & 3; blk = st >> 2; hq0 = kvh * 4; ld = 0; }
        int sb, lsh, w;
        if (blk < 512) { lsh = 13; sb = (blk >> 6) << 13; w = blk & 63; } else { const int bb = blk - 512; lsh = 11; sb = MPROMPT + ((bb >> 4) << 11); w = bb & 15; }
        const int lrs = lsh - ld;
        const int Lr = 1 << lrs, res = w >> (lrs - 7), i0b = (w & ((1 << (lrs - 7)) - 1)) << 7;
        {
            LAS unsigned char* Ks = lds + sub * SUBB; LAS unsigned char* Vs = Ks + W * KP;
            const int ws0 = i0b - R, c = lane & 7;
            const bf16_t* kg = P.Kb + ((size_t)sb + res) * LDK + kvh * 64 + 8 * c;
            const bf16_t* vg = P.Vb + ((size_t)sb + res) * LDK + kvh * 64 + 8 * c;
            constexpr int NSTG = W / (8 * WPS);
            u32x4 kv[NSTG], vv[NSTG];
#pragma unroll
            for (int k = 0; k < NSTG; ++k) {
                const int p = 8 * (k * WPS + wsub) + (lane >> 3); int kj = ws0 + p; kj = kj < 0 ? 0 : kj; kj = kj >= Lr ? Lr - 1 : kj;
                const size_t ro = ((size_t)kj << ld) * LDK;
                kv[k] = *(const u32x4*)(kg + ro); vv[k] = *(const u32x4*)(vg + ro);
            }
#pragma unroll
            for (int k = 0; k < NSTG; ++k) {
                const int p = 8 * (k * WPS + wsub) + (lane >> 3);
                *(LAS u32x4*)(Ks + p * KP + c * 16) = kv[k];
                const int pp = (p & ~12) | ((p & 4) << 1) | ((p & 8) >> 1);
                LAS unsigned short* vp = (LAS unsigned short*)(Vs + (8 * c) * VPB + ((pp ^ (c << 3)) * 2));
                vp[0] = (unsigned short)(vv[k].x & 0xffffu); vp[VPB / 2] = (unsigned short)(vv[k].x >> 16); vp[2 * (VPB / 2)] = (unsigned short)(vv[k].y & 0xffffu); vp[3 * (VPB / 2)] = (unsigned short)(vv[k].y >> 16);
                vp[4 * (VPB / 2)] = (unsigned short)(vv[k].z & 0xffffu); vp[5 * (VPB / 2)] = (unsigned short)(vv[k].z >> 16); vp[6 * (VPB / 2)] = (unsigned short)(vv[k].w & 0xffffu); vp[7 * (VPB / 2)] = (unsigned short)(vv[k].w >> 16);
            }
        }
        bf16x8 qfr[NR][HPT][4];
#pragma unroll
        for (int rd = 0; rd < NR; ++rd) {
            int qtile, hqr;
            if (LB) { const int j = rd * 8 + wave; const int cs = j >= 12 ? 1 : 0; const int rem = j - 12 * cs; qtile = rem & 3; hqr = hq0 + 3 * cs + (rem >> 2); }
            else { qtile = wave & 3; hqr = hq0 + 2 * (wave >> 2); }
            const unsigned rowq_ = (unsigned)sb + ((unsigned)(i0b + 32 * qtile + q) << ld) + res;
            const char* Qp_ = (const char*)(P.Q + hqr * 64) + (rowq_ * LDQ + 4 * hi) * 2u + 8 * hi;
#pragma unroll
            for (int h = 0; h < HPT; ++h)
#pragma unroll
                for (int s = 0; s < 4; ++s) qfr[rd][h][s] = *(const bf16x8*)(Qp_ + (h * 64 + 16 * s) * 2);
        }
        __syncthreads();
#pragma unroll
        for (int rd = 0; rd < NR; ++rd) {
        int csub, qtile, hqr;
        if (LB) { const int j = rd * 8 + wave; csub = j >= 12 ? 1 : 0; const int rem = j - 12 * csub; qtile = rem & 3; hqr = hq0 + 3 * csub + (rem >> 2); }
        else { csub = 0; qtile = wave & 3; hqr = hq0 + 2 * (wave >> 2); }
        const LAS unsigned char* Ks = lds + csub * SUBB; const LAS unsigned char* Vs = Ks + W * KP;
        const int i0 = i0b + 32 * qtile, kro = (32 * qtile + q) * KP + 16 * hi, pos0 = 32 * qtile + 8 * hi;
        const unsigned rowq = (unsigned)sb + ((unsigned)(i0 + q) << ld) + res;
        const unsigned qoff = (rowq * LDQ + 4 * hi) * 2u;
        bf16x8 qf[HPT][4]; float l[HPT], nslope2[HPT]; f32x16 o0[HPT], o1[HPT];
#pragma unroll
        for (int h = 0; h < HPT; ++h) {
#pragma unroll
            for (int s = 0; s < 4; ++s) qf[h][s] = qfr[rd][h][s];
            if (LB) { l[h] = 0.f; } else { l[h] = hi == 0 ? __builtin_amdgcn_exp2f(P.sink[hqr + h] * LOG2E - bnd) : 0.f; }
            nslope2[h] = -exp2f(-8.0f * (float)(hqr + h + 1) / (float)(LB ? B_NQ : A_NQ)) * (float)(1 << ld) * LOG2E;
#pragma unroll
            for (int r = 0; r < 16; ++r) { o0[h][r] = 0.f; o1[h][r] = 0.f; }
        }
        int t_lo = (R - i0) >> 5; if (t_lo < 0) t_lo = 0;
        int t_hi = (Lr - i0 + R) >> 5; if (t_hi > NT) t_hi = NT;
#pragma unroll 1
        for (int i = 0; i < NT; ++i) {
            const int t = TD + ((i & 1) ? -((i + 1) >> 1) : (i >> 1));
            if (t < t_lo || t >= t_hi) continue;
            bf16x8 kf[4], vf[2][2];
#pragma unroll
            for (int s = 0; s < 4; ++s) kf[s] = *(const LAS bf16x8*)(Ks + kro + t * (32 * KP) + 32 * s);
#pragma unroll
            for (int s = 0; s < 2; ++s) { const int pos = pos0 + 32 * t + 16 * s;
                vf[s][0] = *(const LAS bf16x8*)(Vs + vro0 + ((pos ^ dsw0) * 2)); vf[s][1] = *(const LAS bf16x8*)(Vs + vro1 + ((pos ^ dsw1) * 2)); }
            const bool edge = (t == 0) || (t == NT - 1);
            const float xb_ = xq + (float)(32 * t - R);
#pragma unroll
            for (int h = 0; h < HPT; ++h) {
                f32x16 S;
                if (edge || t == TD) {
#pragma unroll
                    for (int r = 0; r < 16; ++r) { const float x = __builtin_fabsf(xb_ + (float)((r & 3) + 8 * (r >> 2))); float c = fmaf(nslope2[h], x, -bnd); if (edge && x > (float)R) c = -INFINITY; S[r] = c; }
                } else {
                    const float sg = t > TD ? nslope2[h] : -nslope2[h]; const float a0 = fmaf(sg, xb_, -bnd);
#pragma unroll
                    for (int r = 0; r < 16; ++r) S[r] = fmaf(sg, (float)((r & 3) + 8 * (r >> 2)), a0);
                }
#pragma unroll
                for (int s = 0; s < 4; ++s) S = __builtin_amdgcn_mfma_f32_32x32x16_bf16(kf[s], qf[h][s], S, 0, 0, 0);
                float ps = 0.f;
#pragma unroll
                for (int r = 0; r < 16; ++r) { const float p = __builtin_amdgcn_exp2f(S[r]); S[r] = p; ps += p; }
                l[h] += ps;
                u32x4 w0, w1;
                w0.x = cvt_pk_bf16(S[0], S[1]); w0.y = cvt_pk_bf16(S[2], S[3]); w0.z = cvt_pk_bf16(S[4], S[5]); w0.w = cvt_pk_bf16(S[6], S[7]);
                w1.x = cvt_pk_bf16(S[8], S[9]); w1.y = cvt_pk_bf16(S[10], S[11]); w1.z = cvt_pk_bf16(S[12], S[13]); w1.w = cvt_pk_bf16(S[14], S[15]);
                const bf16x8 pf0 = __builtin_bit_cast(bf16x8, w0), pf1 = __builtin_bit_cast(bf16x8, w1);
                o0[h] = __builtin_amdgcn_mfma_f32_32x32x16_bf16(vf[0][0], pf0, o0[h], 0, 0, 0);
                o1[h] = __builtin_amdgcn_mfma_f32_32x32x16_bf16(vf[0][1], pf0, o1[h], 0, 0, 0);
                o0[h] = __builtin_amdgcn_mfma_f32_32x32x16_bf16(vf[1][0], pf1, o0[h], 0, 0, 0);
                o1[h] = __builtin_amdgcn_mfma_f32_32x32x16_bf16(vf[1][1], pf1, o1[h], 0, 0, 0);
            }
        }
#pragma unroll
        for (int h = 0; h < HPT; ++h) {
            const float lt = xhalf_sum(l[h]);
            const float inv = 1.0f / lt;
            char* Op = (char*)(P.O + (hqr + h) * 64) + (qoff - 8u * hi) + 16u * hi;
#pragma unroll
            for (int pr = 0; pr < 2; ++pr) {
                const int a0 = 2 * pr, a1 = 2 * pr + 1;
                const unsigned Ax0 = cvt_pk_bf16(o0[h][4 * a0] * inv, o0[h][4 * a0 + 1] * inv), Ay0 = cvt_pk_bf16(o0[h][4 * a0 + 2] * inv, o0[h][4 * a0 + 3] * inv);
                const unsigned Bx0 = cvt_pk_bf16(o0[h][4 * a1] * inv, o0[h][4 * a1 + 1] * inv), By0 = cvt_pk_bf16(o0[h][4 * a1 + 2] * inv, o0[h][4 * a1 + 3] * inv);
                const unsigned Ax1 = cvt_pk_bf16(o1[h][4 * a0] * inv, o1[h][4 * a0 + 1] * inv), Ay1 = cvt_pk_bf16(o1[h][4 * a0 + 2] * inv, o1[h][4 * a0 + 3] * inv);
                const unsigned Bx1 = cvt_pk_bf16(o1[h][4 * a1] * inv, o1[h][4 * a1 + 1] * inv), By1 = cvt_pk_bf16(o1[h][4 * a1 + 2] * inv, o1[h][4 * a1 + 3] * inv);
                const auto sx0 = __builtin_amdgcn_permlane32_swap(Ax0, Bx0, false, false), sy0 = __builtin_amdgcn_permlane32_swap(Ay0, By0, false, false);
                const auto sx1 = __builtin_amdgcn_permlane32_swap(Ax1, Bx1, false, false), sy1 = __builtin_amdgcn_permlane32_swap(Ay1, By1, false, false);
                u32x4 w0, w1; w0.x = sx0[0]; w0.y = sy0[0]; w0.z = sx0[1]; w0.w = sy0[1]; w1.x = sx1[0]; w1.y = sy1[0]; w1.z = sx1[1]; w1.w = sy1[1];
                *(u32x4*)(Op + 32 * pr) = w0; *(u32x4*)(Op + 64 + 32 * pr) = w1;
            }
            if (LB) { if (hi == 0) *(float*)((char*)(P.LSE + hqr + h) + rowq * (B_NQ * 4)) = bnd + log2f(lt); }
        }
        }
        __syncthreads();
    }
}

__device__ __forceinline__ void combine_phase(bf16_t* O, const float* LSE, int gw, int ngw, int lane) {
    int idx[3], g[3], j[3];
#pragma unroll
    for (int i = 0; i < 3; ++i) { idx[i] = lane + 64 * i; const int head = (idx[i] < 144 ? idx[i] : 0) >> 3; g[i] = head / 6; j[i] = head - 6 * g[i]; }
#pragma unroll 1
    for (int row0 = MTOT - 4 - gw * 4; row0 >= 0; row0 -= ngw * 4) {
        u32x4 w[4][3]; float al[4][3];
#pragma unroll
        for (int r = 0; r < 4; ++r) { const bf16_t* rp = O + (size_t)(row0 + r) * (B_NQ * 64);
#pragma unroll
            for (int i = 0; i < 3; ++i) if (i < 2 || idx[i] < 144) w[r][i] = *(const u32x4*)(rp + 8 * idx[i]); }
#pragma unroll
        for (int r = 0; r < 4; ++r) { const float* lp = LSE + (size_t)(row0 + r) * B_NQ;
#pragma unroll
            for (int i = 0; i < 3; ++i) { const float l0 = lp[j[i]], l1 = lp[6 + j[i]], l2 = lp[12 + j[i]]; const float mx = fmaxf(l0, fmaxf(l1, l2));
                const float e0 = __builtin_amdgcn_exp2f(l0 - mx), e1 = __builtin_amdgcn_exp2f(l1 - mx), e2 = __builtin_amdgcn_exp2f(l2 - mx);
                al[r][i] = (g[i] == 0 ? e0 : (g[i] == 1 ? e1 : e2)) / (e0 + e1 + e2); } }
#pragma unroll
        for (int r = 0; r < 4; ++r) { bf16_t* rp = O + (size_t)(row0 + r) * (B_NQ * 64);
#pragma unroll
            for (int i = 0; i < 3; ++i) if (i < 2 || idx[i] < 144) { u32x4 v = w[r][i]; const float a_ = al[r][i];
                v.x = cvt_pk_bf16(bflo(v.x) * a_, bfhi(v.x) * a_); v.y = cvt_pk_bf16(bflo(v.y) * a_, bfhi(v.y) * a_); v.z = cvt_pk_bf16(bflo(v.z) * a_, bfhi(v.z) * a_); v.w = cvt_pk_bf16(bflo(v.w) * a_, bfhi(v.w) * a_);
                *(u32x4*)(rp + 8 * idx[i]) = v; } }
    }
}

__device__ __forceinline__ void p0_item(const float* W0, const float* W1, int K, int Nsrc, bf16_t* WT, int mode, const float* gain, LAS float* scr, int item, int nsg, int lane) {
    const int kb = item / nsg, sg = item - kb * nsg, k0 = 64 * kb, s0 = 32 * sg;
    const float* W = W0; int c0 = s0; bool valid = true;
    if (mode == 1) { const int pn = s0 >> 8, bj = (s0 >> 7) & 1, wc = (s0 >> 5) & 3; c0 = pn * 256 + wc * 64 + bj * 32; valid = c0 < Nsrc; }
    else if (mode == 2) { const int pn = s0 >> 8, bj = (s0 >> 7) & 1, wc = (s0 >> 5) & 3; c0 = pn * 128 + wc * 32; W = bj ? W1 : W0; }
#pragma unroll 8
    for (int i = 0; i < 32; ++i) { const int kk = 2 * i + (lane >> 5); float v = 0.f;
        if (valid) { v = W[(size_t)(k0 + kk) * Nsrc + c0 + (lane & 31)]; if (gain) v *= gain[k0 + kk]; }
        scr[kk * 33 + (lane & 31)] = v; }
    asm volatile("s_waitcnt lgkmcnt(0)" ::: "memory");
    const int c = lane & 7;
#pragma unroll
    for (int j = 0; j < 4; ++j) { const int n = (lane >> 3) + 8 * j; const LAS float* s = scr + (8 * c) * 33 + n;
        u32x4 o; o.x = cvt_pk_bf16(s[0 * 33], s[1 * 33]); o.y = cvt_pk_bf16(s[2 * 33], s[3 * 33]); o.z = cvt_pk_bf16(s[4 * 33], s[5 * 33]); o.w = cvt_pk_bf16(s[6 * 33], s[7 * 33]);
        *(u32x4*)(WT + (size_t)(s0 + n) * K + k0 + 8 * c) = o; }
    asm volatile("s_waitcnt lgkmcnt(0)" ::: "memory");
}

constexpr size_t MiB = 1u << 20;
constexpr size_t W_QKVA = 0, W_QKVB = W_QKVA + (size_t)1536 * 1024 * 2, W_OA = W_QKVB + (size_t)2048 * 1024 * 2, W_OB = W_OA + (size_t)1024 * 1024 * 2,
                 W_GU = W_OB + (size_t)1024 * 1152 * 2, W_DN = W_GU + (size_t)2 * 5632 * 1024 * 2, W_PG = W_DN + (size_t)2 * 1024 * 2816 * 2, W_PP = W_PG + (size_t)2 * 1024 * 1024 * 2,
                 W_END = W_PP + (size_t)2 * 1024 * 256 * 2;
static_assert(W_END <= 56 * MiB, "weights region");
constexpr size_t WS_SSA = 56 * MiB, WS_SSB = 64 * MiB;
constexpr size_t WS_BAR = 62 * MiB, WS_BAR_BYTES = 16384;
constexpr size_t WS_XBB = 72 * MiB;
constexpr size_t WS_PPJ = 264 * MiB;
constexpr size_t WS_BIG = 456 * MiB;
constexpr size_t BIG_Q = 0, BIG_K = 216 * MiB, BIG_VT = 288 * MiB, BIG_LSE = 362 * MiB;
constexpr size_t WS_END = WS_BIG + 528 * MiB;
constexpr size_t OUT_XBA = 0, OUT_PB = 192 * MiB;

constexpr int LDS_BYTES = 147456;
constexpr int NPHASE = 14;

struct Args {
    const float* in[21]; float* out; unsigned char* ws; int ph_lo, ph_hi;
};

#define XB_TMO      128
#define XB_XCNT(j)  (256  + 64 * (j))
#define XB_XSUB(j)  (1280 + 64 * (j))
#define XB_XGEN(j)  (2304 + 64 * (j))
#define XB_TOP      3328
#define XB_TOPGEN   3392
#define XCD_BAR_WORDS 3456
#define XB_SPIN_CAP (1u << 24)
__device__ __forceinline__ unsigned xb_ld(unsigned* p)              { return __hip_atomic_load(p, __ATOMIC_RELAXED, __HIP_MEMORY_SCOPE_AGENT); }
__device__ __forceinline__ unsigned xb_add(unsigned* p, unsigned v) { return __hip_atomic_fetch_add(p, v, __ATOMIC_RELAXED, __HIP_MEMORY_SCOPE_AGENT); }
__device__ __forceinline__ unsigned xb_xcc_id() { return (unsigned)__builtin_amdgcn_s_getreg((3 << 11) | 20) & 0xFu; }
#define XB_SPIN(cond, bar) do { unsigned _sp = 0; while (cond) { __builtin_amdgcn_s_sleep(1); \
    if ((++_sp & 255u) == 0u) { if (xb_ld(&(bar)[XB_TMO])) break; if (_sp > XB_SPIN_CAP) { atomicAdd(&(bar)[XB_TMO], 1u); break; } } } } while (0)
struct XcdBarrier { unsigned* bar; unsigned x; volatile LAS unsigned* st; };
__device__ __forceinline__ XcdBarrier xcd_barrier_post(unsigned* bar, volatile LAS unsigned* st) {
    XcdBarrier b; b.bar = bar; b.x = xb_xcc_id(); b.st = st;
    if (threadIdx.x == 0) (void)xb_add(&bar[XB_XCNT(b.x)], 1u);
    return b;
}
__device__ __forceinline__ void xcd_barrier_complete(unsigned* bar, unsigned x, unsigned& nloc, unsigned& nx) {
    const unsigned G = gridDim.x * gridDim.y * gridDim.z;
    unsigned sum, cnt, mine, sp = 0u;
    for (;;) {
        sum = 0u; cnt = 0u; mine = 0u;
#pragma unroll
        for (unsigned j = 0; j < 16; ++j) { const unsigned c = xb_ld(&bar[XB_XCNT(j)]); sum += c; cnt += (c > 0u) ? 1u : 0u; mine = (j == x) ? c : mine; }
        if (sum == G) break;
        __builtin_amdgcn_s_sleep(1);
        if ((++sp & 255u) == 0u) { if (xb_ld(&bar[XB_TMO])) break; if (sp > XB_SPIN_CAP) { atomicAdd(&bar[XB_TMO], 1u); break; } }
    }
    nloc = mine > 0u ? mine : 1u; nx = cnt > 0u ? cnt : 1u;
}
__device__ __forceinline__ void xcd_barrier(const XcdBarrier& b) {
    asm volatile("s_waitcnt vmcnt(0)" ::: "memory");
    __syncthreads();
    if (threadIdx.x == 0) {
        unsigned* bar = b.bar;
        __builtin_amdgcn_s_waitcnt(0);
        unsigned nloc = b.st[0], nx = b.st[1];
        if (nloc == 0u) { xcd_barrier_complete(bar, b.x, nloc, nx); b.st[0] = nloc; b.st[1] = nx; }
        const unsigned old = xb_add(&bar[XB_XSUB(b.x)], 1u);
        const unsigned gen = old / nloc;
        if (old + 1u == (gen + 1u) * nloc) {
            __builtin_amdgcn_fence(__ATOMIC_RELEASE, "agent");
            asm volatile("s_waitcnt vmcnt(0)" ::: "memory");
            const unsigned og = xb_add(&bar[XB_TOP], 1u);
            const unsigned tg = og / nx;
            if (og + 1u == (tg + 1u) * nx) xb_add(&bar[XB_TOPGEN], 1u);
            else XB_SPIN(xb_ld(&bar[XB_TOPGEN]) == tg, bar);
            __builtin_amdgcn_fence(__ATOMIC_ACQUIRE, "agent");
            xb_add(&bar[XB_XGEN(b.x)], 1u);
            asm volatile("s_waitcnt vmcnt(0)" ::: "memory");
        } else {
            XB_SPIN(xb_ld(&bar[XB_XGEN(b.x)]) == gen, bar);
            __builtin_amdgcn_fence(__ATOMIC_ACQUIRE, "agent");
            asm volatile("s_waitcnt vmcnt(0)" ::: "memory");
        }
    }
    __syncthreads();
}

#define WSP(T, off) ((T*)(ws + (off)))
template <int LAYER>
__device__ __forceinline__ void run_layer(const Args& args, LAS unsigned char* lds, const XcdBarrier& xbar, int lo, int hi) {
#define IN(k) (lo <= (k) && (k) < hi)
#define SEAM(k) do { if (IN(k) && IN((k) + 1)) xcd_barrier(xbar); } while (0)
    constexpr int pb0 = 1 + LAYER * 6;
    constexpr size_t XCUR_IS_OUT = LAYER == 0;
    if (IN(pb0)) {
        unsigned char* ws = args.ws; asm volatile("" : "+s"(ws));
        const int G = gridDim.x, bx = blockIdx.x;
        bf16_t* xcur = LAYER == 0 ? (bf16_t*)((unsigned char*)args.out + OUT_XBA) : WSP(bf16_t, WS_XBB);
        const float* ss_mix = LAYER == 0 ? WSP(float, WS_SSA) : WSP(float, WS_SSB);
        pg8::StaticOrder S;
        if (LAYER == 0) { pg8::Gemm g{xcur, WSP(bf16_t, W_QKVA), MTOT, 1536, 1024}; S.init(MTOT, 1536, G, bx, 1);
            pg8::EpiQKV<false> E{WSP(bf16_t, WS_BIG + BIG_Q), WSP(bf16_t, WS_BIG + BIG_K), WSP(bf16_t, WS_BIG + BIG_VT), ss_mix, args.in[9], args.in[10]}; pg8::gemm_phase(lds, g, S, E); }
        else { pg8::Gemm g{xcur, WSP(bf16_t, W_QKVB), MTOT, 2048, 1024}; S.init(MTOT, 2048, G, bx, 1);
            pg8::EpiQKV<true> E{WSP(bf16_t, WS_BIG + BIG_Q), WSP(bf16_t, WS_BIG + BIG_K), WSP(bf16_t, WS_BIG + BIG_VT), ss_mix, args.in[14], args.in[15]}; pg8::gemm_phase(lds, g, S, E); }
    }
    SEAM(pb0);
    if (IN(pb0 + 1)) {
        unsigned char* ws = args.ws; asm volatile("" : "+s"(ws));
        int tid = threadIdx.x; asm volatile("" : "+v"(tid));
        const int lane = tid & 63, wave = __builtin_amdgcn_readfirstlane(tid >> 6);
        const int G = gridDim.x, bx = blockIdx.x, vcu = (G % 8 == 0) ? (bx % 8) * (G / 8) + bx / 8 : bx;
        bf16_t* Obuf = LAYER == 0 ? WSP(bf16_t, WS_XBB) : (bf16_t*)((unsigned char*)args.out + OUT_XBA);
        AttnP P{WSP(bf16_t, WS_BIG + BIG_Q), Obuf, WSP(bf16_t, WS_BIG + BIG_K), WSP(bf16_t, WS_BIG + BIG_VT), WSP(float, WS_BIG + BIG_LSE), args.in[11], LAYER == 0 ? args.in[9] : args.in[14], LAYER == 0 ? args.in[10] : args.in[15]};
        attn_phase<LAYER == 1>(P, lds, vcu, G, wave, lane);
#if defined(PROBE_DUP_ATTN)
        attn_phase<LAYER == 1>(P, lds, vcu, G, wave, lane);
#endif
        __syncthreads();
    }
    SEAM(pb0 + 1);
    constexpr int pw = pb0 + 2 + LAYER;
    if (LAYER == 1) {
        if (IN(pb0 + 2)) {
            unsigned char* ws = args.ws; asm volatile("" : "+s"(ws));
            int tid = threadIdx.x; asm volatile("" : "+v"(tid));
            const int lane = tid & 63, wave = __builtin_amdgcn_readfirstlane(tid >> 6);
            const int G = gridDim.x, bx = blockIdx.x, vcu = (G % 8 == 0) ? (bx % 8) * (G / 8) + bx / 8 : bx;
            combine_phase((bf16_t*)((unsigned char*)args.out + OUT_XBA), WSP(float, WS_BIG + BIG_LSE), vcu * 8 + wave, G * 8, lane); __syncthreads(); }
        SEAM(pb0 + 2);
    }
    if (IN(pw)) {
        unsigned char* ws = args.ws; asm volatile("" : "+s"(ws));
        const int G = gridDim.x, bx = blockIdx.x;
        bf16_t* xcur = LAYER == 0 ? (bf16_t*)((unsigned char*)args.out + OUT_XBA) : WSP(bf16_t, WS_XBB);
        float* ss_ffn = LAYER == 0 ? WSP(float, WS_SSB) : WSP(float, WS_SSA);
        pg8::StaticOrder S; S.init(MTOT, 1024, G, bx, LAYER == 0 ? 1 : 0);
        pg8::Gemm g{LAYER == 0 ? WSP(bf16_t, WS_XBB) : (bf16_t*)((unsigned char*)args.out + OUT_XBA), LAYER == 0 ? WSP(bf16_t, W_OA) : WSP(bf16_t, W_OB), MTOT, 1024, LAYER == 0 ? 1024 : 1152};
        pg8::EpiResid E{xcur, ss_ffn}; pg8::gemm_phase(lds, g, S, E);
    }
    SEAM(pw);
    if (IN(pw + 1)) {
        unsigned char* ws = args.ws; asm volatile("" : "+s"(ws));
        const int G = gridDim.x, bx = blockIdx.x;
        bf16_t* xcur = LAYER == 0 ? (bf16_t*)((unsigned char*)args.out + OUT_XBA) : WSP(bf16_t, WS_XBB);
        const float* ss_ffn = LAYER == 0 ? WSP(float, WS_SSB) : WSP(float, WS_SSA);
        pg8::StaticOrder S; S.init(MTOT, 5632, G, bx, LAYER == 0 ? 0 : 1);
        pg8::Gemm g{xcur, WSP(bf16_t, W_GU) + (size_t)LAYER * 5632 * 1024, MTOT, 5632, 1024};
        pg8::EpiGU E{WSP(bf16_t, WS_BIG), ss_ffn}; pg8::gemm_phase(lds, g, S, E);
#if defined(PROBE_DUP_GU0)
        if (LAYER == 0) { pg8::gemm_phase(lds, g, S, E); }
#endif
    }
    SEAM(pw + 1);
    if (IN(pw + 2)) {
        unsigned char* ws = args.ws; asm volatile("" : "+s"(ws));
        const int G = gridDim.x, bx = blockIdx.x;
        bf16_t* xcur = LAYER == 0 ? (bf16_t*)((unsigned char*)args.out + OUT_XBA) : WSP(bf16_t, WS_XBB);
        float* ss_ple = LAYER == 0 ? WSP(float, WS_SSA) : WSP(float, WS_SSB);
        pg8::StaticOrder S; S.init(MTOT, 1024, G, bx, LAYER == 0 ? 1 : 0);
        pg8::Gemm g{WSP(bf16_t, WS_BIG), WSP(bf16_t, W_DN) + (size_t)LAYER * 1024 * FFN, MTOT, 1024, FFN};
        pg8::EpiResid E{xcur, ss_ple}; pg8::gemm_phase(lds, g, S, E);
        { const bf16_t* pb = (const bf16_t*)((unsigned char*)args.out + OUT_PB) + (size_t)LAYER * MTOT * PLE;
            pg8::Gemm g2{pb, WSP(bf16_t, W_PP) + (size_t)LAYER * 1024 * 256, MTOT, 1024, 256}; pg8::StaticOrder S2; S2.init(MTOT, 1024, G, bx, LAYER == 0 ? 1 : 0);
            pg8::EpiPlain E2{WSP(bf16_t, WS_PPJ), DM}; pg8::gemm_phase(lds, g2, S2, E2); }
    }
    SEAM(pw + 2);
    if (IN(pw + 3)) {
        unsigned char* ws = args.ws; asm volatile("" : "+s"(ws));
        const int G = gridDim.x, bx = blockIdx.x;
        bf16_t* xcur = LAYER == 0 ? (bf16_t*)((unsigned char*)args.out + OUT_XBA) : WSP(bf16_t, WS_XBB);
        const float* ss_ple = LAYER == 0 ? WSP(float, WS_SSA) : WSP(float, WS_SSB);
        pg8::StaticOrder S; S.init(MTOT, 1024, G, bx, LAYER == 0 ? 0 : 1);
        pg8::Gemm g{xcur, WSP(bf16_t, W_PG) + (size_t)LAYER * 1024 * 1024, MTOT, 1024, 1024};
        if (LAYER == 0) { pg8::EpiPLE<false> E{xcur, WSP(bf16_t, WS_XBB), WSP(bf16_t, WS_PPJ), ss_ple, WSP(float, WS_SSB), nullptr}; pg8::gemm_phase(lds, g, S, E); }
        else { pg8::EpiPLE<true> E{xcur, nullptr, WSP(bf16_t, WS_PPJ), ss_ple, nullptr, args.out}; pg8::gemm_phase(lds, g, S, E); }
#if defined(PROBE_DUP_PLE1)
        if (LAYER == 1) { pg8::EpiPLE<true> E{xcur, nullptr, WSP(bf16_t, WS_PPJ), ss_ple, nullptr, args.out}; pg8::gemm_phase(lds, g, S, E); }
#endif
    }
    if (LAYER == 0) SEAM(pw + 3);
#undef IN
#undef SEAM
}

__device__ __forceinline__ void prologue_phase(const Args& args, LAS unsigned char* lds) {
    unsigned char* ws = args.ws; unsigned char* ob = (unsigned char*)args.out;
    int tid = threadIdx.x; asm volatile("" : "+v"(tid));
    const int lane = tid & 63, wave = __builtin_amdgcn_readfirstlane(tid >> 6);
    const int G = gridDim.x, bx = blockIdx.x, vcu = (G % 8 == 0) ? (bx % 8) * (G / 8) + bx / 8 : bx;
    const int gw = vcu * 8 + wave, ngw = G * 8;
    const float* x_prompt = args.in[0]; const float* x_sample = args.in[1]; const float* p_prompt = args.in[2]; const float* p_sample = args.in[3];
    const float* norm_mix = args.in[4]; const float* norm_ffn = args.in[5]; const float* norm_ple = args.in[6];
    bf16_t* xbA = (bf16_t*)(ob + OUT_XBA); bf16_t* pb = (bf16_t*)(ob + OUT_PB); float* ssA = WSP(float, WS_SSA);
    LAS float* scr = (LAS float*)(lds + wave * 16384);
    constexpr int I_QA = 16 * 48, I_QB = 16 * 64, I_OA = 16 * 32, I_OB = 18 * 32, I_GU = 16 * 176, I_DN = 44 * 32, I_PG = 16 * 32, I_PP = 4 * 32;
    constexpr int NITEMS = I_QA + I_QB + I_OA + I_OB + 2 * I_GU + 2 * I_DN + 2 * I_PG + 2 * I_PP;
#pragma unroll 1
    for (int it = gw; it < NITEMS; it += ngw) {
        int r = it;
        const float* W0; const float* W1 = nullptr; int K, Nsrc, mode, nsg; bf16_t* WT; const float* gain = nullptr;
        if (r < I_QA) { W0 = args.in[7]; K = 1024; Nsrc = 1536; WT = WSP(bf16_t, W_QKVA); mode = 1; gain = norm_mix; nsg = 48; }
        else if ((r -= I_QA) < I_QB) { W0 = args.in[12]; K = 1024; Nsrc = 1920; WT = WSP(bf16_t, W_QKVB); mode = 1; gain = norm_mix + 1024; nsg = 64; }
        else if ((r -= I_QB) < I_OA) { W0 = args.in[8]; K = 1024; Nsrc = 1024; WT = WSP(bf16_t, W_OA); mode = 0; nsg = 32; }
        else if ((r -= I_OA) < I_OB) { W0 = args.in[13]; K = 1152; Nsrc = 1024; WT = WSP(bf16_t, W_OB); mode = 0; nsg = 32; }
        else if ((r -= I_OB) < 2 * I_GU) { const int l = r / I_GU; r -= l * I_GU; W0 = args.in[16] + (size_t)l * 1024 * FFN; W1 = args.in[17] + (size_t)l * 1024 * FFN; K = 1024; Nsrc = FFN;
            WT = WSP(bf16_t, W_GU) + (size_t)l * 5632 * 1024; mode = 2; gain = norm_ffn + l * 1024; nsg = 176; }
        else if ((r -= 2 * I_GU) < 2 * I_DN) { const int l = r / I_DN; r -= l * I_DN; W0 = args.in[18] + (size_t)l * FFN * 1024; K = FFN; Nsrc = 1024; WT = WSP(bf16_t, W_DN) + (size_t)l * 1024 * FFN; mode = 0; nsg = 32; }
        else if ((r -= 2 * I_DN) < 2 * I_PG) { const int l = r / I_PG; r -= l * I_PG; W0 = args.in[19] + (size_t)l * 1024 * 1024; K = 1024; Nsrc = 1024; WT = WSP(bf16_t, W_PG) + (size_t)l * 1024 * 1024; mode = 0; gain = norm_ple + l * 1024; nsg = 32; }
        else { r -= 2 * I_PG; const int l = r / I_PP; r -= l * I_PP; W0 = args.in[20] + (size_t)l * 256 * 1024; K = 256; Nsrc = 1024; WT = WSP(bf16_t, W_PP) + (size_t)l * 1024 * 256; mode = 0; nsg = 32; }
        p0_item(W0, W1, K, Nsrc, WT, mode, gain, scr, r, nsg, lane);
    }
#pragma unroll 1
    for (int r0 = gw * 8; r0 < 2 * MTOT; r0 += ngw * 8) {
        f32x4 v[8];
#pragma unroll
        for (int r = 0; r < 8; ++r) { const int rr = r0 + r; const int l = rr >= MTOT ? 1 : 0, m = rr - l * MTOT;
            const float* pr = m < MPROMPT ? p_prompt + ((size_t)l * MPROMPT + m) * PLE : p_sample + ((size_t)l * (MTOT - MPROMPT) + (m - MPROMPT)) * PLE;
            v[r] = __builtin_nontemporal_load((const f32x4*)pr + lane); }
#pragma unroll
        for (int r = 0; r < 8; ++r) { u32x2 w; w.x = cvt_pk_bf16(v[r].x, v[r].y); w.y = cvt_pk_bf16(v[r].z, v[r].w); ((u32x2*)(pb + (size_t)(r0 + r) * PLE))[lane] = w; }
    }
#pragma unroll 1
    for (int m0 = gw * 4; m0 < MTOT; m0 += ngw * 4) {
        f32x4 v[4][4];
#pragma unroll
        for (int r = 0; r < 4; ++r) { const int m = m0 + r; const float* xr = m < MPROMPT ? x_prompt + (size_t)m * DM : x_sample + (size_t)(m - MPROMPT) * DM; const f32x4* xv = (const f32x4*)xr + lane;
#pragma unroll
            for (int j = 0; j < 4; ++j) v[r][j] = __builtin_nontemporal_load(xv + 64 * j); }
#pragma unroll
        for (int r = 0; r < 4; ++r) { const int m = m0 + r; float s = 0.f;
#pragma unroll
            for (int j = 0; j < 4; ++j) s += (v[r][j].x * v[r][j].x + v[r][j].y * v[r][j].y) + (v[r][j].z * v[r][j].z + v[r][j].w * v[r][j].w);
            s = wave_sum(s);
            u32x2* o8 = (u32x2*)(xbA + (size_t)m * DM) + lane;
#pragma unroll
            for (int j = 0; j < 4; ++j) { u32x2 w; w.x = cvt_pk_bf16(v[r][j].x, v[r][j].y); w.y = cvt_pk_bf16(v[r][j].z, v[r][j].w); o8[64 * j] = w; }
            if (lane < 16) ssA[(size_t)m * 16 + lane] = lane == 0 ? s : 0.f; }
    }
    __syncthreads();
}

__global__ void __launch_bounds__(512, 2) fwd_kernel(Args args) {
    extern __shared__ __attribute__((aligned(16))) unsigned char lds_raw[];
    LAS unsigned char* lds = (LAS unsigned char*)lds_raw;
    cg::grid_group grid = cg::this_grid();
    const int lo = args.ph_lo, hi = args.ph_hi;
    volatile LAS unsigned* bst = (volatile LAS unsigned*)(lds + (LDS_BYTES - 64));
    if (threadIdx.x < 2) bst[threadIdx.x] = 0u;
    __syncthreads();
    const XcdBarrier xbar = xcd_barrier_post((unsigned*)(args.ws + WS_BAR), bst);
    if (lo <= 0 && 0 < hi) prologue_phase(args, lds);
    if (lo <= 0 && 1 < hi) grid.sync();
    run_layer<0>(args, lds, xbar, lo, hi);
    run_layer<1>(args, lds, xbar, lo, hi);
}

extern "C" void kernel_launch(void* const* d_in, const int* in_sizes, int n_in, void* d_out, int out_size, void* d_ws, size_t ws_size, hipStream_t stream) {
    static int grid = 0;
    if (grid == 0) {
        if (n_in != 21 || out_size != MTOT * DM || ws_size < WS_END) { fprintf(stderr, "kernel_launch: unexpected sizes (n_in %d out %d ws %zu, need %zu)\n", n_in, out_size, ws_size, (size_t)WS_END); grid = -1; return; }
        int dev = 0, cus = 0, per_cu = 0;
        (void)hipGetDevice(&dev); (void)hipDeviceGetAttribute(&cus, hipDeviceAttributeMultiprocessorCount, dev);
        if (hipFuncSetAttribute((const void*)fwd_kernel, hipFuncAttributeMaxDynamicSharedMemorySize, LDS_BYTES) != hipSuccess) { fprintf(stderr, "kernel_launch: hipFuncSetAttribute failed\n"); grid = -1; return; }
        (void)hipOccupancyMaxActiveBlocksPerMultiprocessor(&per_cu, (const void*)fwd_kernel, 512, LDS_BYTES);
        (void)hipGetLastError();
        if (per_cu < 1) per_cu = 1;
        grid = cus;
    }
    if (grid < 0) return;
    Args a{};
    for (int i = 0; i < 21; ++i) a.in[i] = (const float*)d_in[i];
    a.out = (float*)d_out; a.ws = (unsigned char*)d_ws;
#if MK_SINGLE
    if (hipMemsetAsync((char*)d_ws + WS_BAR, 0, WS_BAR_BYTES, stream) != hipSuccess) { fprintf(stderr, "kernel_launch: hipMemsetAsync failed\n"); return; }
    a.ph_lo = 0; a.ph_hi = NPHASE;
    void* kargs[] = {&a};
    hipError_t e = hipLaunchCooperativeKernel((const void*)fwd_kernel, dim3(grid), dim3(512), kargs, LDS_BYTES, stream);
    if (e != hipSuccess) fprintf(stderr, "cooperative launch failed: %s (grid %d)\n", hipGetErrorString(e), grid);
#else
    for (int k = 0; k < NPHASE; ++k) {
        a.ph_lo = k; a.ph_hi = k + 1;
        hipLaunchKernelGGL(fwd_kernel, dim3(grid), dim3(512), LDS_BYTES, stream, a);
    }
#endif
}
```
